# Optimizing an MI355X kernel written in HIP

```python
import jax
import jax.numpy as jnp
from jax import lax
import numpy as np

D_MODEL = 1024
BATCH = 8
SEQ = 4096
DEPTH = 4

MLA_HEADS = 4
MLA_Q_LORA = 256
MLA_KV_LORA = 128
MLA_NOPE = 64
MLA_ROPE = 32
MLA_V = 64
ROPE_THETA = 10000.0
LRU_WIDTH = 256
LRU_BLOCKS = 4
LRU_BLOCK_W = LRU_WIDTH // LRU_BLOCKS
CONV_WIDTH = 4
LRU_C = 8.0
SB_HEADS = 4
SB_HD = 64
HG_HEADS = 4
HG_DK = 64
HG_DV = 64
HG_CHUNK = 64
Q_BLOCK = 128
GROUP_W = MLA_HEADS * MLA_V
D_MIX = MLA_HEADS * MLA_V + LRU_WIDTH + SB_HEADS * SB_HD + HG_HEADS * HG_DV
FFN_HIDDEN = -(-8 * D_MODEL // (3 * 256)) * 256
NORM_EPS = 1e-6
MASK_VALUE = -1e30
LB_FLOOR = 1e-30
IN_WIDTHS = (MLA_Q_LORA, MLA_KV_LORA, MLA_ROPE,
             LRU_WIDTH, LRU_WIDTH,
             SB_HEADS * SB_HD, SB_HEADS * SB_HD, SB_HEADS * SB_HD,
             HG_HEADS * HG_DK, HG_HEADS * HG_DK, HG_HEADS * HG_DV, HG_HEADS * HG_DV)
D_IN = sum(IN_WIDTHS)

kernel_name = 'hybrid_parallel_mla_rglru_stickbreak_hgrn2'


def rmsnorm(x, g):
    xf = x.astype(jnp.float32)
    y = xf * lax.rsqrt(jnp.mean(xf * xf, axis=-1, keepdims=True) + NORM_EPS)
    return (y * g.astype(jnp.float32)).astype(x.dtype)


def rope(x, positions):
    half = x.shape[-1] // 2
    inv_freq = ROPE_THETA ** (-jnp.arange(half, dtype=jnp.float32) / half)
    ang = positions.astype(jnp.float32)[..., None] * inv_freq
    ang = ang.reshape(ang.shape[:2] + (1,) * (x.ndim - 3) + (half,))
    cos, sin = jnp.cos(ang), jnp.sin(ang)
    xf = x.astype(jnp.float32)
    x1, x2 = xf[..., :half], xf[..., half:]
    return jnp.concatenate([x1 * cos - x2 * sin, x2 * cos + x1 * sin], axis=-1).astype(x.dtype)


def to_q_blocks(t):
    b, h, s, d = t.shape
    return t.reshape(b, h, s // Q_BLOCK, Q_BLOCK, d).transpose(2, 0, 1, 3, 4)


def from_q_blocks(t):
    n, b, h, qb, d = t.shape
    return t.transpose(1, 2, 0, 3, 4).reshape(b, h, n * qb, d)


def causal_softmax_attention(q, k, v, scale):
    s_len = q.shape[2]
    kpos = jnp.arange(s_len)

    def block(args):
        qb, start = args
        s = jnp.einsum('bhqd,bhkd->bhqk', qb, k).astype(jnp.float32) * scale
        qpos = start + jnp.arange(Q_BLOCK)
        s = jnp.where(kpos[None, :] <= qpos[:, None], s, MASK_VALUE)
        p = jax.nn.softmax(s, axis=-1).astype(v.dtype)
        return jnp.einsum('bhqk,bhkd->bhqd', p, v)

    starts = jnp.arange(s_len // Q_BLOCK) * Q_BLOCK
    return from_q_blocks(lax.map(block, (to_q_blocks(q), starts)))


def stick_breaking_attention(q, k, v):
    s_len = q.shape[2]
    kpos = jnp.arange(s_len)

    def block(args):
        qb, start = args
        z = jnp.einsum('bhqd,bhkd->bhqk', qb, k).astype(jnp.float32) * (SB_HD ** -0.5)
        qpos = start + jnp.arange(Q_BLOCK)
        strict = kpos[None, :] < qpos[:, None]
        log_beta = jax.nn.log_sigmoid(z)
        log_keep = jnp.where(strict, jax.nn.log_sigmoid(-z), 0.0)
        later = lax.cumsum(log_keep, axis=3, reverse=True) - log_keep
        w = jnp.where(strict, jnp.exp(log_beta + later), 0.0)
        return jnp.einsum('bhqk,bhkd->bhqd', w.astype(v.dtype), v)

    starts = jnp.arange(s_len // Q_BLOCK) * Q_BLOCK
    return from_q_blocks(lax.map(block, (to_q_blocks(q), starts)))


def mla_mixer(c_q, c_kv, k_rope, positions, q_norm_g, w_uq, kv_norm_g, w_ukv):
    b, s, _ = c_q.shape
    q = (rmsnorm(c_q, q_norm_g) @ w_uq).reshape(b, s, MLA_HEADS, MLA_NOPE + MLA_ROPE)
    q_nope, q_pe = q[..., :MLA_NOPE], rope(q[..., MLA_NOPE:], positions)
    kv = (rmsnorm(c_kv, kv_norm_g) @ w_ukv).reshape(b, s, MLA_HEADS, MLA_NOPE + MLA_V)
    k_nope, v = kv[..., :MLA_NOPE], kv[..., MLA_NOPE:]
    k_pe = rope(k_rope, positions)
    qh = jnp.concatenate([q_nope, q_pe], axis=-1)
    kh = jnp.concatenate([k_nope, jnp.broadcast_to(k_pe[:, :, None, :], (b, s, MLA_HEADS, MLA_ROPE))], axis=-1)
    out = causal_softmax_attention(qh.transpose(0, 2, 1, 3), kh.transpose(0, 2, 1, 3),
                                   v.transpose(0, 2, 1, 3), (MLA_NOPE + MLA_ROPE) ** -0.5)
    return out.transpose(0, 2, 1, 3).reshape(b, s, MLA_HEADS * MLA_V)


def rglru_mixer(xb, gate, conv_w, conv_b, w_a, b_a, w_x, b_x, lam):
    b, s, w = xb.shape
    xc = lax.conv_general_dilated(xb, conv_w[:, None, :], window_strides=(1,),
                                  padding=((CONV_WIDTH - 1, 0),),
                                  dimension_numbers=('NWC', 'WIO', 'NWC'),
                                  feature_group_count=w) + conv_b
    xblk = xc.reshape(b, s, LRU_BLOCKS, LRU_BLOCK_W)
    rec_gate = jax.nn.sigmoid(jnp.einsum('bsnc,ncd->bsnd', xblk, w_a).reshape(b, s, w) + b_a)
    in_gate = jax.nn.sigmoid(jnp.einsum('bsnc,ncd->bsnd', xblk, w_x).reshape(b, s, w) + b_x)
    log_a = -LRU_C * rec_gate.astype(jnp.float32) * jax.nn.softplus(-lam.astype(jnp.float32))
    a = jnp.exp(log_a)
    u = jnp.sqrt(jnp.maximum(-jnp.expm1(2.0 * log_a), 0.0)) * (in_gate * xc).astype(jnp.float32)

    def combine(left, right):
        a_l, b_l = left
        a_r, b_r = right
        return a_l * a_r, a_r * b_l + b_r

    _, h = lax.associative_scan(combine, (a, u), axis=1)
    return h.astype(xb.dtype) * jax.nn.gelu(gate)


def chunked_gated_recurrence(q, k, v, log_f):
    b, s, h, dk = q.shape
    dv = v.shape[-1]
    n = s // HG_CHUNK

    def chunks(t):
        return t.reshape(b, n, HG_CHUNK, h, t.shape[-1]).transpose(1, 0, 3, 2, 4)

    incl = jnp.tril(jnp.ones((HG_CHUNK, HG_CHUNK), dtype=bool))[:, :, None]

    def step(state, inp):
        qc, kc, vc, gc = inp
        cum = jnp.cumsum(gc, axis=2)
        diff = cum[:, :, :, None, :] - cum[:, :, None, :, :]
        decay = jnp.where(incl, jnp.exp(jnp.where(incl, diff, 0.0)), 0.0)
        scores = jnp.einsum('bhtd,bhsd,bhtsd->bhts', qc, kc, decay)
        o = (jnp.einsum('bhts,bhse->bhte', scores, vc)
             + jnp.einsum('bhtd,bhde->bhte', qc * jnp.exp(cum), state))
        last = cum[:, :, -1, :]
        state = (jnp.exp(last)[..., None] * state
                 + jnp.einsum('bhsd,bhse->bhde', kc * jnp.exp(last[:, :, None, :] - cum), vc))
        return state, o

    state0 = jnp.zeros((b, h, dk, dv), jnp.float32)
    _, o = lax.scan(step, state0, (chunks(q), chunks(k), chunks(v), chunks(log_f)))
    return o.transpose(1, 0, 3, 2, 4).reshape(b, s, h, dv)


def hgrn2_mixer(q, f_logit, i, g, lb, norm_g):
    b, s, _ = q.shape
    lb = lb.astype(jnp.float32)
    fz = f_logit.astype(jnp.float32)
    log_f = jnp.logaddexp(jnp.log(jnp.maximum(lb, LB_FLOOR)), jnp.log1p(-lb) + jax.nn.log_sigmoid(fz))
    key = (1.0 - lb) * jax.nn.sigmoid(-fz)
    heads_k = lambda t: t.reshape(b, s, HG_HEADS, HG_DK)
    o = chunked_gated_recurrence(heads_k(q.astype(jnp.float32)), heads_k(key),
                                 i.astype(jnp.float32).reshape(b, s, HG_HEADS, HG_DV), heads_k(log_f))
    o = rmsnorm(o, norm_g.reshape(HG_HEADS, HG_DV)).reshape(b, s, HG_HEADS * HG_DV)
    return (o * jax.nn.silu(g.astype(jnp.float32))).astype(q.dtype)


def setup_inputs(seed: int = 0) -> dict:
    key = jax.random.key(seed)
    ks = jax.random.split(key, 26)
    nrm = lambda k, shape, scale: jax.random.normal(k, shape, jnp.float32) * scale
    gain = lambda k, shape: 1.0 + 0.05 * jax.random.normal(k, shape, jnp.float32)
    x = jax.random.normal(ks[0], (BATCH, SEQ, D_MODEL), jnp.float32)
    offset = jax.random.randint(ks[1], (BATCH, 1), 0, SEQ, dtype=jnp.int32)
    positions = (offset + jnp.arange(SEQ, dtype=jnp.int32)[None, :]).astype(jnp.int32)
    u = jax.random.uniform(ks[13], (DEPTH, LRU_WIDTH), jnp.float32, minval=0.9, maxval=0.999)
    a0 = u ** (1.0 / LRU_C)
    lru_lambda = jnp.log(a0) - jnp.log1p(-a0)
    return {
        'x': x,
        'positions': positions,
        'ln1_g': gain(ks[2], (DEPTH, D_MODEL)),
        'w_in': nrm(ks[3], (DEPTH, D_MODEL, D_IN), D_MODEL ** -0.5),
        'mla_q_norm_g': gain(ks[4], (DEPTH, MLA_Q_LORA)),
        'mla_w_uq': nrm(ks[5], (DEPTH, MLA_Q_LORA, MLA_HEADS * (MLA_NOPE + MLA_ROPE)), MLA_Q_LORA ** -0.5),
        'mla_kv_norm_g': gain(ks[6], (DEPTH, MLA_KV_LORA)),
        'mla_w_ukv': nrm(ks[7], (DEPTH, MLA_KV_LORA, MLA_HEADS * (MLA_NOPE + MLA_V)), MLA_KV_LORA ** -0.5),
        'lru_conv_w': nrm(ks[8], (DEPTH, CONV_WIDTH, LRU_WIDTH), CONV_WIDTH ** -0.5),
        'lru_conv_b': nrm(ks[9], (DEPTH, LRU_WIDTH), 0.01),
        'lru_w_a': nrm(ks[10], (DEPTH, LRU_BLOCKS, LRU_BLOCK_W, LRU_BLOCK_W), LRU_BLOCK_W ** -0.5),
        'lru_b_a': nrm(ks[11], (DEPTH, LRU_WIDTH), 0.01),
        'lru_w_x': nrm(ks[12], (DEPTH, LRU_BLOCKS, LRU_BLOCK_W, LRU_BLOCK_W), LRU_BLOCK_W ** -0.5),
        'lru_b_x': nrm(ks[14], (DEPTH, LRU_WIDTH), 0.01),
        'lru_lambda': lru_lambda,
        'hgrn_lb_logits': nrm(ks[15], (DEPTH, HG_HEADS * HG_DK), 1.0),
        'hgrn_norm_g': gain(ks[16], (DEPTH, HG_HEADS * HG_DV)),
        'group_norm_g': gain(ks[17], (DEPTH, 3, GROUP_W)),
        'w_out': nrm(ks[18], (DEPTH, D_MIX, D_MODEL), D_MIX ** -0.5),
        'ln2_g': gain(ks[19], (DEPTH, D_MODEL)),
        'w_ffn_gate': nrm(ks[20], (DEPTH, D_MODEL, FFN_HIDDEN), D_MODEL ** -0.5),
        'w_ffn_up': nrm(ks[21], (DEPTH, D_MODEL, FFN_HIDDEN), D_MODEL ** -0.5),
        'w_ffn_down': nrm(ks[22], (DEPTH, FFN_HIDDEN, D_MODEL), FFN_HIDDEN ** -0.5),
        'final_norm_g': gain(ks[23], (D_MODEL,)),
    }


def reference(x, positions, ln1_g, w_in, mla_q_norm_g, mla_w_uq, mla_kv_norm_g, mla_w_ukv,
              lru_conv_w, lru_conv_b, lru_w_a, lru_b_a, lru_w_x, lru_b_x, lru_lambda,
              hgrn_lb_logits, hgrn_norm_g, group_norm_g, w_out, ln2_g,
              w_ffn_gate, w_ffn_up, w_ffn_down, final_norm_g):
    b, s, _ = x.shape
    split_points = np.cumsum(IN_WIDTHS)[:-1].tolist()
    lb_p = jax.nn.softmax(hgrn_lb_logits.astype(jnp.float32), axis=0)
    lower_bounds = jnp.cumsum(lb_p, axis=0) - lb_p[0]
    h = x
    for l in range(DEPTH):
        u = rmsnorm(h, ln1_g[l])
        proj = u @ w_in[l]
        (c_q, c_kv, k_rope, lru_x, lru_gate, sb_q, sb_k, sb_v,
         hg_q, hg_f, hg_i, hg_g) = jnp.split(proj, split_points, axis=-1)
        y_a = mla_mixer(c_q, c_kv, k_rope, positions, mla_q_norm_g[l], mla_w_uq[l],
                        mla_kv_norm_g[l], mla_w_ukv[l])
        y_b = rglru_mixer(lru_x, lru_gate, lru_conv_w[l], lru_conv_b[l], lru_w_a[l], lru_b_a[l],
                          lru_w_x[l], lru_b_x[l], lru_lambda[l])
        sb_heads = lambda t: t.reshape(b, s, SB_HEADS, SB_HD).transpose(0, 2, 1, 3)
        y_c = stick_breaking_attention(sb_heads(sb_q), sb_heads(sb_k), sb_heads(sb_v))
        y_c = y_c.transpose(0, 2, 1, 3).reshape(b, s, SB_HEADS * SB_HD)
        y_d = hgrn2_mixer(hg_q, hg_f, hg_i, hg_g, lower_bounds[l], hgrn_norm_g[l])
        mixed = jnp.concatenate([rmsnorm(y_a, group_norm_g[l, 0]),
                                 rmsnorm(y_b, group_norm_g[l, 1]),
                                 rmsnorm(y_c, group_norm_g[l, 2]),
                                 y_d], axis=-1)
        h = h + mixed @ w_out[l]
        u = rmsnorm(h, ln2_g[l])
        h = h + (jax.nn.silu(u @ w_ffn_gate[l]) * (u @ w_ffn_up[l])) @ w_ffn_down[l]
    return rmsnorm(h, final_norm_g)
```

```cpp
#include <hip/hip_runtime.h>
#include <hip/hip_cooperative_groups.h>
#include <cstdio>
namespace cg = cooperative_groups;

#define LAS __attribute__((address_space(3)))
typedef unsigned short bf16_t;
typedef short bf16x8 __attribute__((ext_vector_type(8)));
typedef float f32x4 __attribute__((ext_vector_type(4)));
typedef float f32x2 __attribute__((ext_vector_type(2)));
typedef float f32x16 __attribute__((ext_vector_type(16)));
typedef unsigned u32x4 __attribute__((ext_vector_type(4)));
typedef unsigned u32x2 __attribute__((ext_vector_type(2)));

constexpr int BATCH = 8, SEQ = 4096, T = BATCH * SEQ, DM = 1024, DEPTH = 4;
constexpr int D_IN = 2720, NPROJ = 2816, FFN = 2816;
constexpr int PLD = 2304;
constexpr int P_LX = 0, P_LG = 256, P_SQ = 512, P_SK = 768, P_SV = 1024, P_HQ = 1280, P_HF = 1536, P_HI = 1792, P_HG = 2048;
constexpr int NTHR = 512, LDS_BYTES = 131072;
constexpr float NORM_EPS = 1e-6f;

constexpr size_t al256(size_t x) { return (x + 255) & ~(size_t)255; }
constexpr size_t WS_WIN = 0;
constexpr size_t WS_WUP = WS_WIN + al256((size_t)NPROJ * DM * 2);
constexpr size_t WS_WOUT = WS_WUP + al256((size_t)1024 * 384 * 2);
constexpr size_t WS_WGU = WS_WOUT + al256((size_t)DM * DM * 2);
constexpr size_t WS_WDN = WS_WGU + al256((size_t)2 * FFN * DM * 2);
constexpr size_t WS_WLRU = WS_WDN + al256((size_t)DM * FFN * 2);
constexpr size_t WS_ROPE = WS_WLRU + al256((size_t)2 * 4 * 64 * 64 * 2);
constexpr size_t WS_U = WS_ROPE + al256((size_t)T * 16 * 8);
constexpr size_t WS_MIX = WS_U + al256((size_t)T * DM * 2);
constexpr size_t WS_LAGG = WS_MIX + al256((size_t)T * DM * 2);
constexpr size_t WS_HDELTA = WS_LAGG + al256((size_t)BATCH * 64 * 256 * 8);
constexpr size_t WS_HDECAY = WS_HDELTA + al256((size_t)2048 * 4096 * 4);
constexpr size_t WS_HSTATE = WS_HDECAY + al256((size_t)2048 * 64 * 4);
constexpr size_t WS_BIG = WS_HSTATE + al256((size_t)2048 * 4096 * 2);
constexpr size_t WS_CQKV = WS_BIG;
constexpr size_t WS_P = WS_CQKV + al256((size_t)T * 384 * 2);
constexpr size_t WS_QM = WS_P + al256((size_t)T * PLD * 2);
constexpr size_t WS_KM = WS_QM + al256((size_t)T * 384 * 2);
constexpr size_t WS_VM = WS_KM + al256((size_t)T * 384 * 2);
constexpr size_t WS_END1 = WS_VM + al256((size_t)T * 256 * 2);
constexpr size_t WS_ACT = WS_BIG;
constexpr size_t WS_END2 = WS_ACT + al256((size_t)T * FFN * 2);
constexpr size_t WS_END = WS_END1 > WS_END2 ? WS_END1 : WS_END2;

struct Params {
    const float* x; const int* pos; const float* ln1_g; const float* w_in; const float* q_norm_g; const float* w_uq; const float* kv_norm_g; const float* w_ukv;
    const float* conv_w; const float* conv_b; const float* w_a; const float* b_a; const float* w_x; const float* b_x; const float* lam;
    const float* lb_logits; const float* hg_norm_g; const float* grp_g; const float* w_out; const float* ln2_g; const float* w_gate; const float* w_up; const float* w_down; const float* fin_g;
    float* out; unsigned char* ws;
};

#define DI __device__ __forceinline__
DI unsigned cvt_pk_bf16(float lo, float hi) { unsigned r; asm("v_cvt_pk_bf16_f32 %0, %1, %2" : "=v"(r) : "v"(lo), "v"(hi)); return r; }
DI bf16_t f2bf(float f) { return (bf16_t)(cvt_pk_bf16(f, 0.f) & 0xffffu); }
DI float bf2f(bf16_t b) { return __uint_as_float(((unsigned)b) << 16); }
DI float bflo(unsigned u) { return __uint_as_float(u << 16); }
DI float bfhi(unsigned u) { return __uint_as_float(u & 0xffff0000u); }
DI float sigmoidf_(float x) { return 1.0f / (1.0f + __expf(-x)); }
DI float wave_sum(float v) { for (int o = 32; o > 0; o >>= 1) v += __shfl_xor(v, o); return v; }

namespace pg8 {
constexpr int BM = 256, BK = 64, HALF = 128, HTB = HALF * BK * 2, STAGE_BYTES = 8 * HTB, NXCD = 8, WGM = 8;
DI int lds_byte(int r, int c) { const int st = (r >> 4) * 2 + (c >> 5), rr = r & 15, cc = c & 31, ob = rr * 64 + cc * 2; return st * 1024 + (ob ^ (((ob >> 9) & 1) << 5)); }
DI void stage_rc(int b, int& R, int& C) { const int st = b / 1024, sb = b % 1024, swz = sb ^ (((sb >> 9) & 1) << 5); R = (st >> 1) * 16 + swz / 64; C = (st & 1) * 32 + (swz % 64) / 2; }
struct Unit { int pm, pn; };
struct Gemm { const bf16_t* A; const bf16_t* Bt; int M, N, K; };
struct StaticOrder {
    int nM, nN, nwg, G, c;
    DI void init(int M, int N, int G_, int c_) { nM = M / BM; nN = N / BM; nwg = nM * nN; G = G_; c = c_; }
    DI bool next(int i, Unit& u) const {
        const long L = (long)i * G + c; if (L >= nwg) return false;
        int wgid = (int)L; { const int q = nwg / NXCD, r = nwg % NXCD, xcd = wgid % NXCD, off = wgid / NXCD; wgid = (xcd < r ? xcd * (q + 1) : r * (q + 1) + (xcd - r) * q) + off; }
        const int nig = WGM * nN, gid = wgid / nig, fm = gid * WGM, gsz = (nM - fm) < WGM ? (nM - fm) : WGM;
        u.pm = fm + ((wgid % nig) % gsz); u.pn = (wgid % nig) / gsz; return true;
    }
};
template <class Epi>
DI void gemm_phase(LAS unsigned char* lds, const Gemm g, const StaticOrder& S, const Epi& E) {
    const int tid = threadIdx.x, wid = __builtin_amdgcn_readfirstlane(tid >> 6), lane = tid & 63, wr = wid >> 2, wc = wid & 3, fr = lane & 15, fq = lane >> 4;
    const int K = g.K, nt = K / BK;
    unsigned voffA[2];
#pragma unroll
    for (int i = 0; i < 2; ++i) { int R, C; stage_rc(tid * 16 + i * 8192, R, C); voffA[i] = (unsigned)(R * K + C) * 2u; }
    const size_t kstep = (size_t)(BK * 2);
    const size_t hstep = (size_t)HALF * K * 2;
    const size_t tstep = 2 * hstep;
    const unsigned ldsw = (unsigned)wid * 1024u;
    const int aoff = lds_byte(wr * 64 + fr, fq * 8), boff = lds_byte(wc * 32 + fr, fq * 8);
#define PG8_SA(b, h) (((b) * 2 + (h)) * HTB)
#define PG8_SB(b, h) ((4 + (b) * 2 + (h)) * HTB)
#define PG8_STAGE(bufoff, gbase, voff) do { _Pragma("unroll") for (int _i = 0; _i < 2; ++_i) \
        __builtin_amdgcn_global_load_lds((const unsigned*)((const char*)(gbase) + (voff)[_i]), (LAS unsigned*)(lds + (bufoff) + ldsw + _i * 8192), 16, 0, 0); } while (0)
#define PG8_LDA(dst, b, h) do { _Pragma("unroll") for (int m = 0; m < 4; ++m) _Pragma("unroll") for (int k = 0; k < 2; ++k) dst[m][k] = *(const LAS bf16x8*)(lds + PG8_SA(b, h) + aoff + m * 2048 + k * 1024); } while (0)
#define PG8_LDB(dst, b, h) do { _Pragma("unroll") for (int n = 0; n < 2; ++n) _Pragma("unroll") for (int k = 0; k < 2; ++k) dst[n][k] = *(const LAS bf16x8*)(lds + PG8_SB(b, h) + boff + n * 2048 + k * 1024); } while (0)
#define PG8_MMA(ai, bj, At, Bt) do { __builtin_amdgcn_s_setprio(1); _Pragma("unroll") for (int m = 0; m < 4; ++m) _Pragma("unroll") for (int n = 0; n < 2; ++n) _Pragma("unroll") for (int k = 0; k < 2; ++k) \
        acc[ai][bj][m][n] = __builtin_amdgcn_mfma_f32_16x16x32_bf16(Bt[n][k], At[m][k], acc[ai][bj][m][n], 0, 0, 0); __builtin_amdgcn_s_setprio(0); } while (0)
#define PG8_WAIT_V(n) asm volatile("s_waitcnt vmcnt(" #n ")" ::: "memory")
#define PG8_WAIT_L(n) asm volatile("s_waitcnt lgkmcnt(" #n ")" ::: "memory")
#define PG8_BAR __builtin_amdgcn_s_barrier()
#define PG8_SCHED __builtin_amdgcn_sched_barrier(0)
    Unit cur, nxt; int ui = 0;
    if (!S.next(0, cur)) return;
    f32x4 acc[2][2][4][2];
#pragma unroll
    for (int a = 0; a < 2; ++a)
#pragma unroll
        for (int b = 0; b < 2; ++b)
#pragma unroll
            for (int m = 0; m < 4; ++m)
#pragma unroll
                for (int n = 0; n < 2; ++n) acc[a][b][m][n] = (f32x4){0.f, 0.f, 0.f, 0.f};
    bf16x8 At[4][2], B0[2][2], B1[2][2];
    const char* cA = (const char*)g.A + (size_t)cur.pm * tstep; const char* cB = (const char*)g.Bt + (size_t)cur.pn * tstep;
    PG8_STAGE(PG8_SB(0, 0), cB, voffA); PG8_STAGE(PG8_SA(0, 0), cA, voffA); PG8_STAGE(PG8_SB(0, 1), cB + hstep, voffA); PG8_STAGE(PG8_SA(0, 1), cA + hstep, voffA);
    if (wr == 1) PG8_BAR;
    PG8_WAIT_V(4); PG8_BAR;
    PG8_STAGE(PG8_SB(1, 0), cB + kstep, voffA); PG8_STAGE(PG8_SA(1, 0), cA + kstep, voffA); PG8_STAGE(PG8_SB(1, 1), cB + hstep + kstep, voffA);
    PG8_WAIT_V(6); PG8_BAR;
    for (;;) {
        const bool has_next = S.next(ui + 1, nxt);
        const char* nA = has_next ? (const char*)g.A + (size_t)nxt.pm * tstep : cA; const char* nB = has_next ? (const char*)g.Bt + (size_t)nxt.pn * tstep : cB;
        for (int t = 0; t < nt; t += 2) {
            const bool last = (t == nt - 2);
            const char* a1 = cA + (size_t)(t + 1) * kstep;
            const char* a2 = last ? nA : cA + (size_t)(t + 2) * kstep; const char* b2 = last ? nB : cB + (size_t)(t + 2) * kstep;
            const char* a3 = a2 + kstep; const char* b3 = b2 + kstep;
            PG8_LDB(B0, 0, 0); PG8_SCHED; PG8_LDA(At, 0, 0); PG8_STAGE(PG8_SA(1, 1), a1 + hstep, voffA);
            PG8_WAIT_L(8); PG8_BAR; PG8_WAIT_L(0); PG8_MMA(0, 0, At, B0); PG8_BAR; PG8_SCHED;
            PG8_LDB(B1, 0, 1); PG8_STAGE(PG8_SB(0, 0), b2, voffA);
            PG8_BAR; PG8_WAIT_L(0); PG8_MMA(0, 1, At, B1); PG8_BAR;
            PG8_LDA(At, 0, 1); PG8_STAGE(PG8_SA(0, 0), a2, voffA);
            PG8_BAR; PG8_WAIT_L(0); PG8_MMA(1, 0, At, B0); PG8_BAR; PG8_SCHED;
            PG8_STAGE(PG8_SB(0, 1), b2 + hstep, voffA);
            PG8_WAIT_V(6); PG8_BAR; PG8_MMA(1, 1, At, B1); PG8_BAR;
            PG8_LDB(B0, 1, 0); PG8_SCHED; PG8_LDA(At, 1, 0); PG8_STAGE(PG8_SA(0, 1), a2 + hstep, voffA);
            PG8_WAIT_L(8); PG8_BAR; PG8_WAIT_L(0); PG8_MMA(0, 0, At, B0); PG8_BAR; PG8_SCHED;
            PG8_LDB(B1, 1, 1); PG8_STAGE(PG8_SB(1, 0), b3, voffA);
            PG8_BAR; PG8_WAIT_L(0); PG8_MMA(0, 1, At, B1); PG8_BAR;
            PG8_LDA(At, 1, 1); PG8_STAGE(PG8_SA(1, 0), a3, voffA);
            PG8_BAR; PG8_WAIT_L(0); PG8_MMA(1, 0, At, B0); PG8_BAR; PG8_SCHED;
            PG8_STAGE(PG8_SB(1, 1), b3 + hstep, voffA);
            PG8_WAIT_V(6); PG8_BAR; PG8_MMA(1, 1, At, B1); PG8_BAR;
        }
        E(acc, cur, wr, wc, fr, fq);
        if (!has_next) break;
#pragma unroll
        for (int a = 0; a < 2; ++a)
#pragma unroll
            for (int b = 0; b < 2; ++b)
#pragma unroll
                for (int m = 0; m < 4; ++m)
#pragma unroll
                    for (int n = 0; n < 2; ++n) acc[a][b][m][n] = (f32x4){0.f, 0.f, 0.f, 0.f};
        cur = nxt; cA = nA; cB = nB; ++ui;
    }
    PG8_WAIT_V(0);
    if (wr == 0) PG8_BAR;
    PG8_BAR;
#undef PG8_SA
#undef PG8_SB
#undef PG8_STAGE
#undef PG8_LDA
#undef PG8_LDB
#undef PG8_MMA
#undef PG8_WAIT_V
#undef PG8_WAIT_L
#undef PG8_BAR
#undef PG8_SCHED
}
}

typedef f32x4 Acc[2][2][4][2];
DI void st_bf16x4(bf16_t* p, f32x4 v) { u32x2 w; w.x = cvt_pk_bf16(v[0], v[1]); w.y = cvt_pk_bf16(v[2], v[3]); *(u32x2*)p = w; }

struct Epi1 {
    bf16_t* cqkv; bf16_t* P; bf16_t* km; const float* rope;
    DI void operator()(const Acc& acc, const pg8::Unit& u, int wr, int wc, int fr, int fq) const {
#pragma unroll
        for (int ai = 0; ai < 2; ++ai)
#pragma unroll
            for (int m = 0; m < 4; ++m) {
                const int row = u.pm * 256 + ai * 128 + wr * 64 + m * 16 + fr;
#pragma unroll
                for (int bj = 0; bj < 2; ++bj) {
                    const int c0 = u.pn * 256 + bj * 128 + wc * 32 + 4 * fq;
                    if (u.pn == 0 || (u.pn == 1 && bj == 0)) {
                        st_bf16x4(cqkv + (size_t)row * 384 + c0, acc[ai][bj][m][0]);
                        st_bf16x4(cqkv + (size_t)row * 384 + c0 + 16, acc[ai][bj][m][1]);
                    } else if (u.pn == 1) {
                        if (wc == 0) {
                            const f32x4 x1 = acc[ai][bj][m][0], x2 = acc[ai][bj][m][1];
                            const f32x4 cs0 = *(const f32x4*)(rope + (size_t)row * 32 + 8 * fq), cs1 = *(const f32x4*)(rope + (size_t)row * 32 + 8 * fq + 4);
                            f32x4 o1, o2;
                            o1[0] = x1[0] * cs0[0] - x2[0] * cs0[1]; o2[0] = x2[0] * cs0[0] + x1[0] * cs0[1];
                            o1[1] = x1[1] * cs0[2] - x2[1] * cs0[3]; o2[1] = x2[1] * cs0[2] + x1[1] * cs0[3];
                            o1[2] = x1[2] * cs1[0] - x2[2] * cs1[1]; o2[2] = x2[2] * cs1[0] + x1[2] * cs1[1];
                            o1[3] = x1[3] * cs1[2] - x2[3] * cs1[3]; o2[3] = x2[3] * cs1[2] + x1[3] * cs1[3];
#pragma unroll
                            for (int h = 0; h < 4; ++h) { st_bf16x4(km + (size_t)row * 384 + h * 96 + 64 + 4 * fq, o1); st_bf16x4(km + (size_t)row * 384 + h * 96 + 80 + 4 * fq, o2); }
                        }
                    } else {
                        st_bf16x4(P + (size_t)row * PLD + (c0 - 512), acc[ai][bj][m][0]);
                        st_bf16x4(P + (size_t)row * PLD + (c0 - 512) + 16, acc[ai][bj][m][1]);
                    }
                }
            }
    }
};
struct Epi2 {
    bf16_t* qm; bf16_t* km; bf16_t* vm; const float* rope;
    DI void operator()(const Acc& acc, const pg8::Unit& u, int wr, int wc, int fr, int fq) const {
#pragma unroll
        for (int ai = 0; ai < 2; ++ai)
#pragma unroll
            for (int m = 0; m < 4; ++m) {
                const int row = u.pm * 256 + ai * 128 + wr * 64 + m * 16 + fr;
#pragma unroll
                for (int bj = 0; bj < 2; ++bj) {
                    const int grp = u.pn * 8 + bj * 4 + wc;
                    const f32x4 x1 = acc[ai][bj][m][0], x2 = acc[ai][bj][m][1];
                    if (grp < 12) {
                        bf16_t* d = qm + (size_t)row * 384 + grp * 32 + 4 * fq;
                        if (grp % 3 == 2) {
                            const f32x4 cs0 = *(const f32x4*)(rope + (size_t)row * 32 + 8 * fq), cs1 = *(const f32x4*)(rope + (size_t)row * 32 + 8 * fq + 4);
                            f32x4 o1, o2;
                            o1[0] = x1[0] * cs0[0] - x2[0] * cs0[1]; o2[0] = x2[0] * cs0[0] + x1[0] * cs0[1];
                            o1[1] = x1[1] * cs0[2] - x2[1] * cs0[3]; o2[1] = x2[1] * cs0[2] + x1[1] * cs0[3];
                            o1[2] = x1[2] * cs1[0] - x2[2] * cs1[1]; o2[2] = x2[2] * cs1[0] + x1[2] * cs1[1];
                            o1[3] = x1[3] * cs1[2] - x2[3] * cs1[3]; o2[3] = x2[3] * cs1[2] + x1[3] * cs1[3];
                            st_bf16x4(d, o1); st_bf16x4(d + 16, o2);
                        } else { st_bf16x4(d, x1); st_bf16x4(d + 16, x2); }
                    } else if (grp < 28) {
                        const int g2 = grp - 12, head = g2 >> 2, sub = g2 & 3;
                        bf16_t* d = (sub < 2) ? km + (size_t)row * 384 + head * 96 + sub * 32 + 4 * fq : vm + (size_t)row * 256 + head * 64 + (sub - 2) * 32 + 4 * fq;
                        st_bf16x4(d, x1); st_bf16x4(d + 16, x2);
                    }
                }
            }
    }
};
struct EpiRes {
    const float* hin; float* hout;
    DI void operator()(const Acc& acc, const pg8::Unit& u, int wr, int wc, int fr, int fq) const {
#pragma unroll
        for (int ai = 0; ai < 2; ++ai)
#pragma unroll
            for (int m = 0; m < 4; ++m) {
                const size_t off = (size_t)(u.pm * 256 + ai * 128 + wr * 64 + m * 16 + fr) * DM + u.pn * 256 + wc * 32 + 4 * fq;
#pragma unroll
                for (int bj = 0; bj < 2; ++bj)
#pragma unroll
                    for (int n = 0; n < 2; ++n) { const f32x4 b = *(const f32x4*)(hin + off + bj * 128 + n * 16); *(f32x4*)(hout + off + bj * 128 + n * 16) = b + acc[ai][bj][m][n]; }
            }
    }
};
struct EpiGU {
    bf16_t* act;
    DI void operator()(const Acc& acc, const pg8::Unit& u, int wr, int wc, int fr, int fq) const {
#pragma unroll
        for (int ai = 0; ai < 2; ++ai)
#pragma unroll
            for (int m = 0; m < 4; ++m) {
                const int row = u.pm * 256 + ai * 128 + wr * 64 + m * 16 + fr;
#pragma unroll
                for (int bj = 0; bj < 2; ++bj) {
                    const int grp = u.pn * 8 + bj * 4 + wc;
                    const f32x4 g = acc[ai][bj][m][0], up = acc[ai][bj][m][1];
                    f32x4 o;
#pragma unroll
                    for (int j = 0; j < 4; ++j) o[j] = g[j] * sigmoidf_(g[j]) * up[j];
                    st_bf16x4(act + (size_t)row * FFN + grp * 16 + 4 * fq, o);
                }
            }
    }
};

DI int rowmap(int mode, int n) { return mode == 0 ? n : mode == 1 ? (n < 416 ? n : n + 96) : mode == 2 ? (32 * (n >> 4) + (n & 15)) : (32 * (n >> 4) + 16 + (n & 15)); }
DI void transpose_tile(const float* W, int K, int N, bf16_t* dst, int ldd, int mode, int tile, LAS float* lds) {
    const int ntn = (N + 63) / 64, kt = tile / ntn, nt = tile % ntn, k0 = kt * 64, n0 = nt * 64, tid = threadIdx.x;
#pragma unroll
    for (int i = 0; i < 8; ++i) { const int idx = tid + i * NTHR, r = idx >> 6, c = idx & 63; lds[r * 65 + c] = (n0 + c < N) ? W[(size_t)(k0 + r) * N + n0 + c] : 0.f; }
    __syncthreads();
#pragma unroll
    for (int i = 0; i < 8; ++i) { const int idx = tid + i * NTHR, rr = idx >> 6, cc = idx & 63; if (n0 + rr < N) dst[(size_t)rowmap(mode, n0 + rr) * ldd + k0 + cc] = f2bf(lds[cc * 65 + rr]); }
    __syncthreads();
}
DI void rms_rows(const float* src, const float* g, bf16_t* dst, float* dstf) {
    const int lane = threadIdx.x & 63, wv = threadIdx.x >> 6;
    for (int row = blockIdx.x * 8 + wv; row < T; row += gridDim.x * 8) {
        const float* s = src + (size_t)row * DM;
        f32x4 v[4]; float ss = 0.f;
#pragma unroll
        for (int i = 0; i < 4; ++i) { v[i] = *(const f32x4*)(s + i * 256 + lane * 4); ss += v[i][0] * v[i][0] + v[i][1] * v[i][1] + v[i][2] * v[i][2] + v[i][3] * v[i][3]; }
        ss = wave_sum(ss);
        const float rs = rsqrtf(ss * (1.0f / DM) + NORM_EPS);
#pragma unroll
        for (int i = 0; i < 4; ++i) { const f32x4 gg = *(const f32x4*)(g + i * 256 + lane * 4); f32x4 o = v[i] * rs * gg;
            if (dst) st_bf16x4(dst + (size_t)row * DM + i * 256 + lane * 4, o); else *(f32x4*)(dstf + (size_t)row * DM + i * 256 + lane * 4) = o; }
    }
}

DI void phase_convert(const Params& p, int l, LAS unsigned char* lds) {
    unsigned char* ws = p.ws;
    bf16_t* Win = (bf16_t*)(ws + WS_WIN); bf16_t* Wup = (bf16_t*)(ws + WS_WUP); bf16_t* Wout = (bf16_t*)(ws + WS_WOUT);
    bf16_t* Wgu = (bf16_t*)(ws + WS_WGU); bf16_t* Wdn = (bf16_t*)(ws + WS_WDN); bf16_t* Wlru = (bf16_t*)(ws + WS_WLRU);
    LAS float* lf = (LAS float*)lds;
    const int n0 = 16 * 43, n1 = 256, n2 = 16 * 44, n3 = 16 * 44, n4 = 44 * 16, ntot = n0 + n1 + n2 + n3 + n4;
    for (int t = blockIdx.x; t < ntot; t += gridDim.x) {
        if (t < n0) transpose_tile(p.w_in + (size_t)l * DM * D_IN, DM, D_IN, Win, DM, 1, t, lf);
        else if (t < n0 + n1) transpose_tile(p.w_out + (size_t)l * DM * DM, DM, DM, Wout, DM, 0, t - n0, lf);
        else if (t < n0 + n1 + n2) transpose_tile(p.w_gate + (size_t)l * DM * FFN, DM, FFN, Wgu, DM, 2, t - n0 - n1, lf);
        else if (t < n0 + n1 + n2 + n3) transpose_tile(p.w_up + (size_t)l * DM * FFN, DM, FFN, Wgu, DM, 3, t - n0 - n1 - n2, lf);
        else transpose_tile(p.w_down + (size_t)l * FFN * DM, FFN, DM, Wdn, FFN, 0, t - n0 - n1 - n2 - n3, lf);
    }
    const int gtid = blockIdx.x * NTHR + threadIdx.x, gn = gridDim.x * NTHR;
    for (int i = gtid; i < 96 * DM; i += gn) Win[(size_t)416 * DM + i] = 0;
    const float* wuq = p.w_uq + (size_t)l * 256 * 384; const float* wukv = p.w_ukv + (size_t)l * 128 * 512;
    for (int i = gtid; i < 1024 * 384; i += gn) {
        const int n = i / 384, k = i % 384; float v = 0.f;
        if (n < 384) { if (k < 256) v = wuq[(size_t)k * 384 + n]; }
        else if (n < 896) { if (k >= 256) v = wukv[(size_t)(k - 256) * 512 + (n - 384)]; }
        Wup[i] = f2bf(v);
    }
    for (int i = gtid; i < 2 * 4 * 64 * 64; i += gn) {
        const int ty = i >> 14, n = (i >> 12) & 3, d = (i >> 6) & 63, c = i & 63;
        const float* w = (ty ? p.w_x : p.w_a) + (size_t)l * 4 * 64 * 64;
        Wlru[i] = f2bf(w[(n * 64 + c) * 64 + d]);
    }
    if (l == 0) {
        float* rt = (float*)(ws + WS_ROPE);
        for (int i = gtid; i < T * 16; i += gn) {
            const int row = i >> 4, j = i & 15;
            const float inv = powf(10000.0f, -(float)j / 16.0f);
            const float ang = (float)p.pos[row] * inv;
            float s, c; sincosf(ang, &s, &c);
            rt[2 * i] = c; rt[2 * i + 1] = s;
        }
    }
}

DI void phase_norm_cqkv(const Params& p, int l) {
    bf16_t* cq = (bf16_t*)(p.ws + WS_CQKV);
    const float* gq = p.q_norm_g + l * 256; const float* gk = p.kv_norm_g + l * 128;
    const int lane = threadIdx.x & 63, wv = threadIdx.x >> 6;
    for (int row = blockIdx.x * 8 + wv; row < T; row += gridDim.x * 8) {
        bf16_t* r = cq + (size_t)row * 384;
        const u32x2 a = *(const u32x2*)(r + lane * 4); const unsigned b = *(const unsigned*)(r + 256 + lane * 2);
        const float a0 = bflo(a.x), a1 = bfhi(a.x), a2 = bflo(a.y), a3 = bfhi(a.y), b0 = bflo(b), b1 = bfhi(b);
        const float sq = wave_sum(a0 * a0 + a1 * a1 + a2 * a2 + a3 * a3), sk = wave_sum(b0 * b0 + b1 * b1);
        const float rq = rsqrtf(sq * (1.0f / 256) + NORM_EPS), rk = rsqrtf(sk * (1.0f / 128) + NORM_EPS);
        const f32x4 g4 = *(const f32x4*)(gq + lane * 4); const f32x2 g2 = *(const f32x2*)(gk + lane * 2);
        u32x2 o; o.x = cvt_pk_bf16(a0 * rq * g4[0], a1 * rq * g4[1]); o.y = cvt_pk_bf16(a2 * rq * g4[2], a3 * rq * g4[3]);
        *(u32x2*)(r + lane * 4) = o; *(unsigned*)(r + 256 + lane * 2) = cvt_pk_bf16(b0 * rk * g2[0], b1 * rk * g2[1]);
    }
}
DI void phase_group_norm(const Params& p, int l) {
    bf16_t* mix = (bf16_t*)(p.ws + WS_MIX);
    const int lane = threadIdx.x & 63, wv = threadIdx.x >> 6;
    for (int row = blockIdx.x * 8 + wv; row < T; row += gridDim.x * 8) {
#pragma unroll
        for (int gi = 0; gi < 3; ++gi) {
            bf16_t* r = mix + (size_t)row * DM + gi * 256 + lane * 4;
            const u32x2 a = *(const u32x2*)r;
            const float a0 = bflo(a.x), a1 = bfhi(a.x), a2 = bflo(a.y), a3 = bfhi(a.y);
            const float ss = wave_sum(a0 * a0 + a1 * a1 + a2 * a2 + a3 * a3);
            const float rs = rsqrtf(ss * (1.0f / 256) + NORM_EPS);
            const f32x4 g4 = *(const f32x4*)(p.grp_g + (size_t)l * 768 + gi * 256 + lane * 4);
            u32x2 o; o.x = cvt_pk_bf16(a0 * rs * g4[0], a1 * rs * g4[1]); o.y = cvt_pk_bf16(a2 * rs * g4[2], a3 * rs * g4[3]);
            *(u32x2*)r = o;
        }
    }
}

DI void naive_mla(const Params& p, int item) {
    const bf16_t* qm = (const bf16_t*)(p.ws + WS_QM); const bf16_t* km = (const bf16_t*)(p.ws + WS_KM); const bf16_t* vm = (const bf16_t*)(p.ws + WS_VM);
    bf16_t* mix = (bf16_t*)(p.ws + WS_MIX);
    const int b = item >> 5, h = (item >> 3) & 3, qc = item & 7;
    const int t = qc * 512 + threadIdx.x;
    const size_t row = (size_t)b * SEQ + t;
    float q[96], o[64];
#pragma unroll
    for (int i = 0; i < 48; ++i) { const unsigned u = *(const unsigned*)(qm + row * 384 + h * 96 + 2 * i); q[2 * i] = bflo(u); q[2 * i + 1] = bfhi(u); }
#pragma unroll
    for (int i = 0; i < 64; ++i) o[i] = 0.f;
    float mx = -1e30f, l = 0.f;
    const int kend = __builtin_amdgcn_readfirstlane(qc * 512 + (threadIdx.x | 63));
    const float scale = 0.10206207261596577f;
    for (int k = 0; k <= kend; ++k) {
        const unsigned* kr = (const unsigned*)(km + ((size_t)b * SEQ + k) * 384 + h * 96);
        const unsigned* vr = (const unsigned*)(vm + ((size_t)b * SEQ + k) * 256 + h * 64);
        float s = 0.f;
#pragma unroll
        for (int i = 0; i < 48; ++i) { const unsigned u = kr[i]; s += q[2 * i] * bflo(u) + q[2 * i + 1] * bfhi(u); }
        s *= scale;
        const bool valid = k <= t;
        const float mn = valid ? fmaxf(mx, s) : mx;
        const float alpha = __expf(mx - mn), pr = valid ? __expf(s - mn) : 0.f;
        l = l * alpha + pr; mx = mn;
#pragma unroll
        for (int i = 0; i < 32; ++i) { const unsigned u = vr[i]; o[2 * i] = o[2 * i] * alpha + pr * bflo(u); o[2 * i + 1] = o[2 * i + 1] * alpha + pr * bfhi(u); }
    }
    const float inv = 1.0f / l;
#pragma unroll
    for (int i = 0; i < 32; ++i) *(unsigned*)(mix + row * DM + h * 64 + 2 * i) = cvt_pk_bf16(o[2 * i] * inv, o[2 * i + 1] * inv);
}
DI void naive_sb(const Params& p, int item) {
    const bf16_t* P = (const bf16_t*)(p.ws + WS_P); bf16_t* mix = (bf16_t*)(p.ws + WS_MIX);
    const int b = item >> 5, h = (item >> 3) & 3, qc = item & 7;
    const int t = qc * 512 + threadIdx.x;
    const size_t row = (size_t)b * SEQ + t;
    float q[64], o[64];
#pragma unroll
    for (int i = 0; i < 32; ++i) { const unsigned u = *(const unsigned*)(P + row * PLD + P_SQ + h * 64 + 2 * i); q[2 * i] = bflo(u); q[2 * i + 1] = bfhi(u); }
#pragma unroll
    for (int i = 0; i < 64; ++i) o[i] = 0.f;
    float R = 0.f;
    const int kend = __builtin_amdgcn_readfirstlane(qc * 512 + (threadIdx.x | 63));
    for (int k = kend - 1; k >= 0; --k) {
        const unsigned* kr = (const unsigned*)(P + ((size_t)b * SEQ + k) * PLD + P_SK + h * 64);
        const unsigned* vr = (const unsigned*)(P + ((size_t)b * SEQ + k) * PLD + P_SV + h * 64);
        float z = 0.f;
#pragma unroll
        for (int i = 0; i < 32; ++i) { const unsigned u = kr[i]; z += q[2 * i] * bflo(u) + q[2 * i + 1] * bfhi(u); }
        z *= 0.125f;
        const bool valid = k < t;
        const float lk = -(fmaxf(z, 0.f) + log1pf(__expf(-fabsf(z))));
        const float w = valid ? __expf(z + lk + R) : 0.f;
        R += valid ? lk : 0.f;
#pragma unroll
        for (int i = 0; i < 32; ++i) { const unsigned u = vr[i]; o[2 * i] += w * bflo(u); o[2 * i + 1] += w * bfhi(u); }
    }
#pragma unroll
    for (int i = 0; i < 32; ++i) *(unsigned*)(mix + row * DM + 512 + h * 64 + 2 * i) = cvt_pk_bf16(o[2 * i], o[2 * i + 1]);
}
DI void naive_lru_gates(const Params& p, int l, LAS unsigned char* lds) {
    const bf16_t* P = (const bf16_t*)(p.ws + WS_P);
    float* Aa = (float*)(p.ws + WS_U); float* Uu = Aa + (size_t)T * 256;
    LAS float* xs = (LAS float*)lds;
    const int tl = threadIdx.x >> 8, ch = threadIdx.x & 255, n = ch >> 6, d = ch & 63;
    const float* cw = p.conv_w + l * 4 * 256; const float cb = p.conv_b[l * 256 + ch];
    const float* wa = p.w_a + (size_t)l * 4 * 4096 + n * 4096; const float* wx = p.w_x + (size_t)l * 4 * 4096 + n * 4096;
    const float ba = p.b_a[l * 256 + ch], bx = p.b_x[l * 256 + ch];
    const float lam = p.lam[l * 256 + ch];
    const float sp = fmaxf(-lam, 0.f) + log1pf(__expf(-fabsf(lam)));
    for (int tile = blockIdx.x; tile < T / 2; tile += gridDim.x) {
        const int row = tile * 2 + tl, s = row & (SEQ - 1);
        float xc = cb;
#pragma unroll
        for (int j = 0; j < 4; ++j) { const int ss = s - 3 + j; if (ss >= 0) xc += cw[j * 256 + ch] * bf2f(P[(size_t)(row - 3 + j) * PLD + P_LX + ch]); }
        xs[tl * 256 + ch] = xc;
        __syncthreads();
        float ra = ba, rx = bx;
#pragma unroll 4
        for (int c = 0; c < 64; ++c) { const float xv = xs[tl * 256 + n * 64 + c]; ra += xv * wa[c * 64 + d]; rx += xv * wx[c * 64 + d]; }
        const float la = -8.0f * sigmoidf_(ra) * sp;
        const float a = __expf(la);
        const float uu = sqrtf(fmaxf(-expm1f(2.0f * la), 0.f)) * sigmoidf_(rx) * xc;
        Aa[(size_t)row * 256 + ch] = a; Uu[(size_t)row * 256 + ch] = uu;
        __syncthreads();
    }
}
DI float gelu_tanh(float x) { const float u = 0.7978845608028654f * (x + 0.044715f * x * x * x); return 0.5f * x * (1.0f + tanhf(u)); }
DI void naive_lru_scan(const Params& p, int item) {
    const bf16_t* P = (const bf16_t*)(p.ws + WS_P); bf16_t* mix = (bf16_t*)(p.ws + WS_MIX);
    const float* Aa = (const float*)(p.ws + WS_U); const float* Uu = Aa + (size_t)T * 256;
    const int id = item * 512 + threadIdx.x, b = id >> 8, ch = id & 255;
    float h = 0.f;
#pragma unroll 8
    for (int s = 0; s < SEQ; ++s) {
        const size_t row = (size_t)b * SEQ + s;
        h = Aa[row * 256 + ch] * h + Uu[row * 256 + ch];
        mix[row * DM + 256 + ch] = f2bf(h * gelu_tanh(bf2f(P[row * PLD + P_LG + ch])));
    }
}
DI float hg_lower_bound(const Params& p, int l, int c) {
    float v[DEPTH], mx = -1e30f, s = 0.f;
#pragma unroll
    for (int i = 0; i < DEPTH; ++i) { v[i] = p.lb_logits[i * 256 + c]; mx = fmaxf(mx, v[i]); }
#pragma unroll
    for (int i = 0; i < DEPTH; ++i) { v[i] = __expf(v[i] - mx); s += v[i]; }
    float lb = 0.f;
#pragma unroll
    for (int i = 1; i < DEPTH; ++i) if (i <= l) lb += v[i];
    return lb / s;
}
DI void naive_hgrn(const Params& p, int l, int item, LAS unsigned char* lds) {
    const bf16_t* P = (const bf16_t*)(p.ws + WS_P); bf16_t* mix = (bf16_t*)(p.ws + WS_MIX);
    LAS float* sf = (LAS float*)lds; LAS float* sk = sf + 128; LAS float* sq = sk + 128; LAS float* sv = sq + 128; LAS float* red = sv + 128;
    const int b = item >> 2, h = item & 3, tid = threadIdx.x, e = tid & 63, dg = tid >> 6;
    const float lb = hg_lower_bound(p, l, h * 64 + e);
    const float ng = p.hg_norm_g[l * 256 + h * 64 + e];
    float st[8];
#pragma unroll
    for (int i = 0; i < 8; ++i) st[i] = 0.f;
    for (int s = 0; s < SEQ; ++s) {
        const size_t row = (size_t)b * SEQ + s; const int pb = (s & 1) * 64;
        if (tid < 64) {
            const float fz = bf2f(P[row * PLD + P_HF + h * 64 + e]);
            sf[pb + e] = fmaxf(lb, 1e-30f) + (1.0f - lb) * sigmoidf_(fz);
            sk[pb + e] = (1.0f - lb) * sigmoidf_(-fz);
            sq[pb + e] = bf2f(P[row * PLD + P_HQ + h * 64 + e]);
        } else if (tid < 128) sv[pb + e] = bf2f(P[row * PLD + P_HI + h * 64 + e]);
        __syncthreads();
        const float v = sv[pb + e]; float part = 0.f;
#pragma unroll
        for (int i = 0; i < 8; ++i) { const int d = dg * 8 + i; st[i] = sf[pb + d] * st[i] + sk[pb + d] * v; part += st[i] * sq[pb + d]; }
        red[(s & 1) * 512 + dg * 64 + e] = part;
        __syncthreads();
        if (tid < 64) {
            float o = 0.f;
#pragma unroll
            for (int i = 0; i < 8; ++i) o += red[(s & 1) * 512 + i * 64 + e];
            const float ss = wave_sum(o * o);
            const float rs = rsqrtf(ss * (1.0f / 64) + NORM_EPS);
            const float g = bf2f(P[row * PLD + P_HG + h * 64 + e]);
            mix[row * DM + 768 + h * 64 + e] = f2bf(o * rs * ng * g * sigmoidf_(g));
        }
    }
    __syncthreads();
}

constexpr int PH_PER_LAYER = 10, PH_FINAL = DEPTH * PH_PER_LAYER, PH_TOTAL = PH_FINAL + 1;

DI void run_phase(const Params& p, int l, int ph, LAS unsigned char* lds) {
    unsigned char* ws = p.ws;
    const float* hin = (l == 0) ? p.x : p.out;
    if (ph == PH_PER_LAYER) { rms_rows(p.out, p.fin_g, nullptr, p.out); return; }
    switch (ph) {
    case 0: phase_convert(p, l, lds); rms_rows(hin, p.ln1_g + l * DM, (bf16_t*)(ws + WS_U), nullptr); break;
    case 1: { pg8::Gemm g{(const bf16_t*)(ws + WS_U), (const bf16_t*)(ws + WS_WIN), T, NPROJ, DM}; pg8::StaticOrder S; S.init(T, NPROJ, gridDim.x, blockIdx.x);
        Epi1 E{(bf16_t*)(ws + WS_CQKV), (bf16_t*)(ws + WS_P), (bf16_t*)(ws + WS_KM), (const float*)(ws + WS_ROPE)}; pg8::gemm_phase(lds, g, S, E); } break;
    case 2: phase_norm_cqkv(p, l); naive_lru_gates(p, l, lds); break;
    case 3: { pg8::Gemm g{(const bf16_t*)(ws + WS_CQKV), (const bf16_t*)(ws + WS_WUP), T, 1024, 384}; pg8::StaticOrder S; S.init(T, 1024, gridDim.x, blockIdx.x);
        Epi2 E{(bf16_t*)(ws + WS_QM), (bf16_t*)(ws + WS_KM), (bf16_t*)(ws + WS_VM), (const float*)(ws + WS_ROPE)}; pg8::gemm_phase(lds, g, S, E); } break;
    case 4: {
        for (int it = blockIdx.x; it < 256 + 256 + 4 + 32; it += gridDim.x) {
            if (it < 256) naive_mla(p, it); else if (it < 512) naive_sb(p, it - 256); else if (it < 516) naive_lru_scan(p, it - 512); else naive_hgrn(p, l, it - 516, lds);
        } } break;
    case 5: phase_group_norm(p, l); break;
    case 6: { pg8::Gemm g{(const bf16_t*)(ws + WS_MIX), (const bf16_t*)(ws + WS_WOUT), T, DM, DM}; pg8::StaticOrder S; S.init(T, DM, gridDim.x, blockIdx.x);
        EpiRes E{hin, p.out}; pg8::gemm_phase(lds, g, S, E); } break;
    case 7: rms_rows(p.out, p.ln2_g + l * DM, (bf16_t*)(ws + WS_U), nullptr); break;
    case 8: { pg8::Gemm g{(const bf16_t*)(ws + WS_U), (const bf16_t*)(ws + WS_WGU), T, 2 * FFN, DM}; pg8::StaticOrder S; S.init(T, 2 * FFN, gridDim.x, blockIdx.x);
        EpiGU E{(bf16_t*)(ws + WS_ACT)}; pg8::gemm_phase(lds, g, S, E); } break;
    case 9: { pg8::Gemm g{(const bf16_t*)(ws + WS_ACT), (const bf16_t*)(ws + WS_WDN), T, DM, FFN}; pg8::StaticOrder S; S.init(T, DM, gridDim.x, blockIdx.x);
        EpiRes E{p.out, p.out}; pg8::gemm_phase(lds, g, S, E); } break;
    }
}

template <int PH>
__global__ void __launch_bounds__(NTHR, 2) phase_kernel(Params p, int l) {
    extern __shared__ __attribute__((aligned(16))) unsigned char lds_raw[];
    LAS unsigned char* lds = (LAS unsigned char*)lds_raw;
    run_phase(p, l, PH, lds);
}
template <int PH>
static void launch_phase(const Params& p, int l, hipStream_t stream) {
    static bool attr = false;
    if (!attr) { hipFuncSetAttribute((const void*)phase_kernel<PH>, hipFuncAttributeMaxDynamicSharedMemorySize, LDS_BYTES); attr = true; }
    hipLaunchKernelGGL(phase_kernel<PH>, dim3(256), dim3(NTHR), LDS_BYTES, stream, p, l);
}

extern "C" void kernel_launch(void* const* d_in, const int* in_sizes, int n_in, void* d_out, int out_size, void* d_ws, size_t ws_size, hipStream_t stream) {
    static int inited = 0;
    if (!inited) {
        if (ws_size < WS_END) { fprintf(stderr, "kernel_launch: workspace too small: %zu < %zu\n", ws_size, (size_t)WS_END); return; }
        inited = 1;
    }
    Params p{};
    p.x = (const float*)d_in[0]; p.pos = (const int*)d_in[1]; p.ln1_g = (const float*)d_in[2]; p.w_in = (const float*)d_in[3]; p.q_norm_g = (const float*)d_in[4];
    p.w_uq = (const float*)d_in[5]; p.kv_norm_g = (const float*)d_in[6]; p.w_ukv = (const float*)d_in[7]; p.conv_w = (const float*)d_in[8]; p.conv_b = (const float*)d_in[9];
    p.w_a = (const float*)d_in[10]; p.b_a = (const float*)d_in[11]; p.w_x = (const float*)d_in[12]; p.b_x = (const float*)d_in[13]; p.lam = (const float*)d_in[14];
    p.lb_logits = (const float*)d_in[15]; p.hg_norm_g = (const float*)d_in[16]; p.grp_g = (const float*)d_in[17]; p.w_out = (const float*)d_in[18]; p.ln2_g = (const float*)d_in[19];
    p.w_gate = (const float*)d_in[20]; p.w_up = (const float*)d_in[21]; p.w_down = (const float*)d_in[22]; p.fin_g = (const float*)d_in[23];
    p.out = (float*)d_out; p.ws = (unsigned char*)d_ws;
    for (int l = 0; l < DEPTH; ++l) {
        launch_phase<0>(p, l, stream); launch_phase<1>(p, l, stream); launch_phase<2>(p, l, stream); launch_phase<3>(p, l, stream); launch_phase<4>(p, l, stream);
        launch_phase<5>(p, l, stream); launch_phase<6>(p, l, stream); launch_phase<7>(p, l, stream); launch_phase<8>(p, l, stream); launch_phase<9>(p, l, stream);
    }
    launch_phase<10>(p, 0, stream);
}
```

```cpp
#include <hip/hip_runtime.h>
#include <hip/hip_cooperative_groups.h>
#include <cstdio>
namespace cg = cooperative_groups;

#define LAS __attribute__((address_space(3)))
typedef unsigned short bf16_t;
typedef short bf16x8 __attribute__((ext_vector_type(8)));
typedef float f32x4 __attribute__((ext_vector_type(4)));
typedef float f32x2 __attribute__((ext_vector_type(2)));
typedef float f32x16 __attribute__((ext_vector_type(16)));
typedef unsigned u32x4 __attribute__((ext_vector_type(4)));
typedef unsigned u32x2 __attribute__((ext_vector_type(2)));

constexpr int BATCH = 8, SEQ = 4096, T = BATCH * SEQ, DM = 1024, DEPTH = 4;
constexpr int D_IN = 2720, NPROJ = 2816, FFN = 2816;
constexpr int PLD = 2304;
constexpr int P_LX = 0, P_LG = 256, P_SQ = 512, P_SK = 768, P_SV = 1024, P_HQ = 1280, P_HF = 1536, P_HI = 1792, P_HG = 2048;
constexpr int NTHR = 512, LDS_BYTES = 131072;
constexpr float NORM_EPS = 1e-6f;

constexpr size_t al256(size_t x) { return (x + 255) & ~(size_t)255; }
constexpr size_t WS_WIN = 0;
constexpr size_t WS_WUP = WS_WIN + al256((size_t)NPROJ * DM * 2);
constexpr size_t WS_WOUT = WS_WUP + al256((size_t)1024 * 384 * 2);
constexpr size_t WS_WGU = WS_WOUT + al256((size_t)DM * DM * 2);
constexpr size_t WS_WDN = WS_WGU + al256((size_t)2 * FFN * DM * 2);
constexpr size_t WS_WLRU = WS_WDN + al256((size_t)DM * FFN * 2);
constexpr size_t WS_ROPE = WS_WLRU + al256((size_t)2 * 4 * 64 * 64 * 2);
constexpr size_t WS_U = WS_ROPE + al256((size_t)T * 16 * 8);
constexpr size_t WS_MIX = WS_U + al256((size_t)T * DM * 2);
constexpr size_t WS_LAGG = WS_MIX + al256((size_t)T * DM * 2);
constexpr size_t WS_HDELTA = WS_LAGG + al256((size_t)BATCH * 64 * 256 * 8);
constexpr size_t WS_HDECAY = WS_HDELTA + al256((size_t)2048 * 4096 * 4);
constexpr size_t WS_HSTATE = WS_HDECAY + al256((size_t)2048 * 64 * 4);
constexpr size_t WS_BIG = WS_HSTATE + al256((size_t)2048 * 4096 * 2);
constexpr size_t WS_CQKV = WS_BIG;
constexpr size_t WS_P = WS_CQKV + al256((size_t)T * 384 * 2);
constexpr size_t WS_QM = WS_P + al256((size_t)T * PLD * 2);
constexpr size_t WS_KM = WS_QM + al256((size_t)T * 384 * 2);
constexpr size_t WS_VM = WS_KM + al256((size_t)T * 384 * 2);
constexpr size_t WS_END1 = WS_VM + al256((size_t)T * 256 * 2);
constexpr size_t WS_ACT = WS_BIG;
constexpr size_t WS_END2 = WS_ACT + al256((size_t)T * FFN * 2);
constexpr size_t WS_END = WS_END1 > WS_END2 ? WS_END1 : WS_END2;

struct Params {
    const float* x; const int* pos; const float* ln1_g; const float* w_in; const float* q_norm_g; const float* w_uq; const float* kv_norm_g; const float* w_ukv;
    const float* conv_w; const float* conv_b; const float* w_a; const float* b_a; const float* w_x; const float* b_x; const float* lam;
    const float* lb_logits; const float* hg_norm_g; const float* grp_g; const float* w_out; const float* ln2_g; const float* w_gate; const float* w_up; const float* w_down; const float* fin_g;
    float* out; unsigned char* ws;
};

#define DI __device__ __forceinline__
typedef const Params __attribute__((address_space(4)))* PP;
DI int ltid() { int t = threadIdx.x; asm volatile("" : "+v"(t)); return t; }
DI int lbid() { int b = blockIdx.x; asm volatile("" : "+s"(b)); return b; }
DI unsigned cvt_pk_bf16(float lo, float hi) { unsigned r; asm("v_cvt_pk_bf16_f32 %0, %1, %2" : "=v"(r) : "v"(lo), "v"(hi)); return r; }
DI bf16_t f2bf(float f) { return (bf16_t)(cvt_pk_bf16(f, 0.f) & 0xffffu); }
DI float bf2f(bf16_t b) { return __uint_as_float(((unsigned)b) << 16); }
DI float bflo(unsigned u) { return __uint_as_float(u << 16); }
DI float bfhi(unsigned u) { return __uint_as_float(u & 0xffff0000u); }
DI float sigmoidf_(float x) { return 1.0f / (1.0f + __expf(-x)); }
DI float wave_sum(float v) { for (int o = 32; o > 0; o >>= 1) v += __shfl_xor(v, o); return v; }

namespace pg8 {
constexpr int BM = 256, BK = 64, HALF = 128, HTB = HALF * BK * 2, STAGE_BYTES = 8 * HTB, NXCD = 8, WGM = 8;
DI int lds_byte(int r, int c) { const int st = (r >> 4) * 2 + (c >> 5), rr = r & 15, cc = c & 31, ob = rr * 64 + cc * 2; return st * 1024 + (ob ^ (((ob >> 9) & 1) << 5)); }
DI void stage_rc(int b, int& R, int& C) { const int st = b / 1024, sb = b % 1024, swz = sb ^ (((sb >> 9) & 1) << 5); R = (st >> 1) * 16 + swz / 64; C = (st & 1) * 32 + (swz % 64) / 2; }
struct Unit { int pm, pn; };
struct Gemm { const bf16_t* A; const bf16_t* Bt; int M, N, K; };
struct StaticOrder {
    int nM, nN, nwg, G, c;
    DI void init(int M, int N, int G_, int c_) { nM = M / BM; nN = N / BM; nwg = nM * nN; G = G_; c = c_; }
    DI bool next(int i, Unit& u) const {
        const long L = (long)i * G + c; if (L >= nwg) return false;
        int wgid = (int)L; { const int q = nwg / NXCD, r = nwg % NXCD, xcd = wgid % NXCD, off = wgid / NXCD; wgid = (xcd < r ? xcd * (q + 1) : r * (q + 1) + (xcd - r) * q) + off; }
        const int nig = WGM * nN, gid = wgid / nig, fm = gid * WGM, gsz = (nM - fm) < WGM ? (nM - fm) : WGM;
        u.pm = fm + ((wgid % nig) % gsz); u.pn = (wgid % nig) / gsz; return true;
    }
};
template <class Epi>
DI void gemm_phase(LAS unsigned char* lds, const Gemm g, const StaticOrder& S, const Epi& E) {
    const int tid = ltid(), wid = __builtin_amdgcn_readfirstlane(tid >> 6), lane = tid & 63, wr = wid >> 2, wc = wid & 3, fr = lane & 15, fq = lane >> 4;
    const int K = g.K, nt = K / BK;
    unsigned voffA[2];
#pragma unroll
    for (int i = 0; i < 2; ++i) { int R, C; stage_rc(tid * 16 + i * 8192, R, C); voffA[i] = (unsigned)(R * K + C) * 2u; }
    const size_t kstep = (size_t)(BK * 2);
    const size_t hstep = (size_t)HALF * K * 2;
    const size_t tstep = 2 * hstep;
    const unsigned ldsw = (unsigned)wid * 1024u;
    const int aoff = lds_byte(wr * 64 + fr, fq * 8), boff = lds_byte(wc * 32 + fr, fq * 8);
#define PG8_SA(b, h) (((b) * 2 + (h)) * HTB)
#define PG8_SB(b, h) ((4 + (b) * 2 + (h)) * HTB)
#define PG8_STAGE(bufoff, gbase, voff) do { _Pragma("unroll") for (int _i = 0; _i < 2; ++_i) \
        __builtin_amdgcn_global_load_lds((const unsigned*)((const char*)(gbase) + (voff)[_i]), (LAS unsigned*)(lds + (bufoff) + ldsw + _i * 8192), 16, 0, 0); } while (0)
#define PG8_LDA(dst, b, h) do { _Pragma("unroll") for (int m = 0; m < 4; ++m) _Pragma("unroll") for (int k = 0; k < 2; ++k) dst[m][k] = *(const LAS bf16x8*)(lds + PG8_SA(b, h) + aoff + m * 2048 + k * 1024); } while (0)
#define PG8_LDB(dst, b, h) do { _Pragma("unroll") for (int n = 0; n < 2; ++n) _Pragma("unroll") for (int k = 0; k < 2; ++k) dst[n][k] = *(const LAS bf16x8*)(lds + PG8_SB(b, h) + boff + n * 2048 + k * 1024); } while (0)
#define PG8_MMA(ai, bj, At, Bt) do { __builtin_amdgcn_s_setprio(1); _Pragma("unroll") for (int m = 0; m < 4; ++m) _Pragma("unroll") for (int n = 0; n < 2; ++n) _Pragma("unroll") for (int k = 0; k < 2; ++k) \
        acc[ai][bj][m][n] = __builtin_amdgcn_mfma_f32_16x16x32_bf16(Bt[n][k], At[m][k], acc[ai][bj][m][n], 0, 0, 0); __builtin_amdgcn_s_setprio(0); } while (0)
#define PG8_WAIT_V(n) asm volatile("s_waitcnt vmcnt(" #n ")" ::: "memory")
#define PG8_WAIT_L(n) asm volatile("s_waitcnt lgkmcnt(" #n ")" ::: "memory")
#define PG8_BAR __builtin_amdgcn_s_barrier()
#define PG8_SCHED __builtin_amdgcn_sched_barrier(0)
    Unit cur, nxt; int ui = 0;
    if (!S.next(0, cur)) return;
    f32x4 acc[2][2][4][2];
#pragma unroll
    for (int a = 0; a < 2; ++a)
#pragma unroll
        for (int b = 0; b < 2; ++b)
#pragma unroll
            for (int m = 0; m < 4; ++m)
#pragma unroll
                for (int n = 0; n < 2; ++n) acc[a][b][m][n] = (f32x4){0.f, 0.f, 0.f, 0.f};
    bf16x8 At[4][2], B0[2][2], B1[2][2];
    const char* cA = (const char*)g.A + (size_t)cur.pm * tstep; const char* cB = (const char*)g.Bt + (size_t)cur.pn * tstep;
    PG8_STAGE(PG8_SB(0, 0), cB, voffA); PG8_STAGE(PG8_SA(0, 0), cA, voffA); PG8_STAGE(PG8_SB(0, 1), cB + hstep, voffA); PG8_STAGE(PG8_SA(0, 1), cA + hstep, voffA);
    if (wr == 1) PG8_BAR;
    PG8_WAIT_V(4); PG8_BAR;
    PG8_STAGE(PG8_SB(1, 0), cB + kstep, voffA); PG8_STAGE(PG8_SA(1, 0), cA + kstep, voffA); PG8_STAGE(PG8_SB(1, 1), cB + hstep + kstep, voffA);
    PG8_WAIT_V(6); PG8_BAR;
    for (;;) {
        const bool has_next = S.next(ui + 1, nxt);
        const char* nA = has_next ? (const char*)g.A + (size_t)nxt.pm * tstep : cA; const char* nB = has_next ? (const char*)g.Bt + (size_t)nxt.pn * tstep : cB;
        for (int t = 0; t < nt; t += 2) {
            const bool last = (t == nt - 2);
            const char* a1 = cA + (size_t)(t + 1) * kstep;
            const char* a2 = last ? nA : cA + (size_t)(t + 2) * kstep; const char* b2 = last ? nB : cB + (size_t)(t + 2) * kstep;
            const char* a3 = a2 + kstep; const char* b3 = b2 + kstep;
            PG8_LDB(B0, 0, 0); PG8_SCHED; PG8_LDA(At, 0, 0); PG8_STAGE(PG8_SA(1, 1), a1 + hstep, voffA);
            PG8_WAIT_L(8); PG8_BAR; PG8_WAIT_L(0); PG8_MMA(0, 0, At, B0); PG8_BAR; PG8_SCHED;
            PG8_LDB(B1, 0, 1); PG8_STAGE(PG8_SB(0, 0), b2, voffA);
            PG8_BAR; PG8_WAIT_L(0); PG8_MMA(0, 1, At, B1); PG8_BAR;
            PG8_LDA(At, 0, 1); PG8_STAGE(PG8_SA(0, 0), a2, voffA);
            PG8_BAR; PG8_WAIT_L(0); PG8_MMA(1, 0, At, B0); PG8_BAR; PG8_SCHED;
            PG8_STAGE(PG8_SB(0, 1), b2 + hstep, voffA);
            PG8_WAIT_V(6); PG8_BAR; PG8_MMA(1, 1, At, B1); PG8_BAR;
            PG8_LDB(B0, 1, 0); PG8_SCHED; PG8_LDA(At, 1, 0); PG8_STAGE(PG8_SA(0, 1), a2 + hstep, voffA);
            PG8_WAIT_L(8); PG8_BAR; PG8_WAIT_L(0); PG8_MMA(0, 0, At, B0); PG8_BAR; PG8_SCHED;
            PG8_LDB(B1, 1, 1); PG8_STAGE(PG8_SB(1, 0), b3, voffA);
            PG8_BAR; PG8_WAIT_L(0); PG8_MMA(0, 1, At, B1); PG8_BAR;
            PG8_LDA(At, 1, 1); PG8_STAGE(PG8_SA(1, 0), a3, voffA);
            PG8_BAR; PG8_WAIT_L(0); PG8_MMA(1, 0, At, B0); PG8_BAR; PG8_SCHED;
            PG8_STAGE(PG8_SB(1, 1), b3 + hstep, voffA);
            PG8_WAIT_V(6); PG8_BAR; PG8_MMA(1, 1, At, B1); PG8_BAR;
        }
        E(acc, cur, wr, wc, fr, fq);
        if (!has_next) break;
#pragma unroll
        for (int a = 0; a < 2; ++a)
#pragma unroll
            for (int b = 0; b < 2; ++b)
#pragma unroll
                for (int m = 0; m < 4; ++m)
#pragma unroll
                    for (int n = 0; n < 2; ++n) acc[a][b][m][n] = (f32x4){0.f, 0.f, 0.f, 0.f};
        cur = nxt; cA = nA; cB = nB; ++ui;
    }
    PG8_WAIT_V(0);
    if (wr == 0) PG8_BAR;
    PG8_BAR;
#undef PG8_SA
#undef PG8_SB
#undef PG8_STAGE
#undef PG8_LDA
#undef PG8_LDB
#undef PG8_MMA
#undef PG8_WAIT_V
#undef PG8_WAIT_L
#undef PG8_BAR
#undef PG8_SCHED
}
}

typedef f32x4 Acc[2][2][4][2];
DI void st_bf16x4(bf16_t* p, f32x4 v) { u32x2 w; w.x = cvt_pk_bf16(v[0], v[1]); w.y = cvt_pk_bf16(v[2], v[3]); *(u32x2*)p = w; }

struct Epi1 {
    bf16_t* cqkv; bf16_t* P; bf16_t* km; const float* rope;
    DI void operator()(const Acc& acc, const pg8::Unit& u, int wr, int wc, int fr, int fq) const {
#pragma unroll
        for (int ai = 0; ai < 2; ++ai)
#pragma unroll
            for (int m = 0; m < 4; ++m) {
                const int row = u.pm * 256 + ai * 128 + wr * 64 + m * 16 + fr;
#pragma unroll
                for (int bj = 0; bj < 2; ++bj) {
                    const int c0 = u.pn * 256 + bj * 128 + wc * 32 + 4 * fq;
                    if (u.pn == 0 || (u.pn == 1 && bj == 0)) {
                        st_bf16x4(cqkv + (size_t)row * 384 + c0, acc[ai][bj][m][0]);
                        st_bf16x4(cqkv + (size_t)row * 384 + c0 + 16, acc[ai][bj][m][1]);
                    } else if (u.pn == 1) {
                        if (wc == 0) {
                            const f32x4 x1 = acc[ai][bj][m][0], x2 = acc[ai][bj][m][1];
                            const f32x4 cs0 = *(const f32x4*)(rope + (size_t)row * 32 + 8 * fq), cs1 = *(const f32x4*)(rope + (size_t)row * 32 + 8 * fq + 4);
                            f32x4 o1, o2;
                            o1[0] = x1[0] * cs0[0] - x2[0] * cs0[1]; o2[0] = x2[0] * cs0[0] + x1[0] * cs0[1];
                            o1[1] = x1[1] * cs0[2] - x2[1] * cs0[3]; o2[1] = x2[1] * cs0[2] + x1[1] * cs0[3];
                            o1[2] = x1[2] * cs1[0] - x2[2] * cs1[1]; o2[2] = x2[2] * cs1[0] + x1[2] * cs1[1];
                            o1[3] = x1[3] * cs1[2] - x2[3] * cs1[3]; o2[3] = x2[3] * cs1[2] + x1[3] * cs1[3];
#pragma unroll
                            for (int h = 0; h < 4; ++h) { st_bf16x4(km + (size_t)row * 384 + h * 96 + 64 + 4 * fq, o1); st_bf16x4(km + (size_t)row * 384 + h * 96 + 80 + 4 * fq, o2); }
                        }
                    } else {
                        st_bf16x4(P + (size_t)row * PLD + (c0 - 512), acc[ai][bj][m][0]);
                        st_bf16x4(P + (size_t)row * PLD + (c0 - 512) + 16, acc[ai][bj][m][1]);
                    }
                }
            }
    }
};
struct Epi2 {
    bf16_t* qm; bf16_t* km; bf16_t* vm; const float* rope;
    DI void operator()(const Acc& acc, const pg8::Unit& u, int wr, int wc, int fr, int fq) const {
#pragma unroll
        for (int ai = 0; ai < 2; ++ai)
#pragma unroll
            for (int m = 0; m < 4; ++m) {
                const int row = u.pm * 256 + ai * 128 + wr * 64 + m * 16 + fr;
#pragma unroll
                for (int bj = 0; bj < 2; ++bj) {
                    const int grp = u.pn * 8 + bj * 4 + wc;
                    const f32x4 x1 = acc[ai][bj][m][0], x2 = acc[ai][bj][m][1];
                    if (grp < 12) {
                        bf16_t* d = qm + (size_t)row * 384 + grp * 32 + 4 * fq;
                        if (grp % 3 == 2) {
                            const f32x4 cs0 = *(const f32x4*)(rope + (size_t)row * 32 + 8 * fq), cs1 = *(const f32x4*)(rope + (size_t)row * 32 + 8 * fq + 4);
                            f32x4 o1, o2;
                            o1[0] = x1[0] * cs0[0] - x2[0] * cs0[1]; o2[0] = x2[0] * cs0[0] + x1[0] * cs0[1];
                            o1[1] = x1[1] * cs0[2] - x2[1] * cs0[3]; o2[1] = x2[1] * cs0[2] + x1[1] * cs0[3];
                            o1[2] = x1[2] * cs1[0] - x2[2] * cs1[1]; o2[2] = x2[2] * cs1[0] + x1[2] * cs1[1];
                            o1[3] = x1[3] * cs1[2] - x2[3] * cs1[3]; o2[3] = x2[3] * cs1[2] + x1[3] * cs1[3];
                            st_bf16x4(d, o1); st_bf16x4(d + 16, o2);
                        } else { st_bf16x4(d, x1); st_bf16x4(d + 16, x2); }
                    } else if (grp < 28) {
                        const int g2 = grp - 12, head = g2 >> 2, sub = g2 & 3;
                        bf16_t* d = (sub < 2) ? km + (size_t)row * 384 + head * 96 + sub * 32 + 4 * fq : vm + (size_t)row * 256 + head * 64 + (sub - 2) * 32 + 4 * fq;
                        st_bf16x4(d, x1); st_bf16x4(d + 16, x2);
                    }
                }
            }
    }
};
struct EpiRes {
    const float* hin; float* hout;
    DI void operator()(const Acc& acc, const pg8::Unit& u, int wr, int wc, int fr, int fq) const {
#pragma unroll
        for (int ai = 0; ai < 2; ++ai)
#pragma unroll
            for (int m = 0; m < 4; ++m) {
                const size_t off = (size_t)(u.pm * 256 + ai * 128 + wr * 64 + m * 16 + fr) * DM + u.pn * 256 + wc * 32 + 4 * fq;
#pragma unroll
                for (int bj = 0; bj < 2; ++bj)
#pragma unroll
                    for (int n = 0; n < 2; ++n) { const f32x4 b = *(const f32x4*)(hin + off + bj * 128 + n * 16); *(f32x4*)(hout + off + bj * 128 + n * 16) = b + acc[ai][bj][m][n]; }
            }
    }
};
struct EpiGU {
    bf16_t* act;
    DI void operator()(const Acc& acc, const pg8::Unit& u, int wr, int wc, int fr, int fq) const {
#pragma unroll
        for (int ai = 0; ai < 2; ++ai)
#pragma unroll
            for (int m = 0; m < 4; ++m) {
                const int row = u.pm * 256 + ai * 128 + wr * 64 + m * 16 + fr;
#pragma unroll
                for (int bj = 0; bj < 2; ++bj) {
                    const int grp = u.pn * 8 + bj * 4 + wc;
                    const f32x4 g = acc[ai][bj][m][0], up = acc[ai][bj][m][1];
                    f32x4 o;
#pragma unroll
                    for (int j = 0; j < 4; ++j) o[j] = g[j] * sigmoidf_(g[j]) * up[j];
                    st_bf16x4(act + (size_t)row * FFN + grp * 16 + 4 * fq, o);
                }
            }
    }
};

DI int rowmap(int mode, int n) { return mode == 0 ? n : mode == 1 ? (n < 416 ? n : n + 96) : mode == 2 ? (32 * (n >> 4) + (n & 15)) : (32 * (n >> 4) + 16 + (n & 15)); }
DI void transpose_tile(const float* W, int K, int N, bf16_t* dst, int ldd, int mode, int tile, LAS float* lds) {
    const int ntn = (N + 63) / 64, kt = tile / ntn, nt = tile % ntn, k0 = kt * 64, n0 = nt * 64, tid = ltid();
#pragma unroll
    for (int i = 0; i < 8; ++i) { const int idx = tid + i * NTHR, r = idx >> 6, c = idx & 63; lds[r * 65 + c] = (n0 + c < N) ? W[(size_t)(k0 + r) * N + n0 + c] : 0.f; }
    __syncthreads();
#pragma unroll
    for (int i = 0; i < 8; ++i) { const int idx = tid + i * NTHR, rr = idx >> 6, cc = idx & 63; if (n0 + rr < N) dst[(size_t)rowmap(mode, n0 + rr) * ldd + k0 + cc] = f2bf(lds[cc * 65 + rr]); }
    __syncthreads();
}
DI void rms_rows(const float* src, const float* g, bf16_t* dst, float* dstf) {
    const int lane = ltid() & 63, wv = ltid() >> 6;
    for (int row = lbid() * 8 + wv; row < T; row += gridDim.x * 8) {
        const float* s = src + (size_t)row * DM;
        f32x4 v[4]; float ss = 0.f;
#pragma unroll
        for (int i = 0; i < 4; ++i) { v[i] = *(const f32x4*)(s + i * 256 + lane * 4); ss += v[i][0] * v[i][0] + v[i][1] * v[i][1] + v[i][2] * v[i][2] + v[i][3] * v[i][3]; }
        ss = wave_sum(ss);
        const float rs = rsqrtf(ss * (1.0f / DM) + NORM_EPS);
#pragma unroll
        for (int i = 0; i < 4; ++i) { const f32x4 gg = *(const f32x4*)(g + i * 256 + lane * 4); f32x4 o = v[i] * rs * gg;
            if (dst) st_bf16x4(dst + (size_t)row * DM + i * 256 + lane * 4, o); else *(f32x4*)(dstf + (size_t)row * DM + i * 256 + lane * 4) = o; }
    }
}

DI void phase_convert(PP p, int l, LAS unsigned char* lds) {
    unsigned char* ws = p->ws;
    bf16_t* Win = (bf16_t*)(ws + WS_WIN); bf16_t* Wup = (bf16_t*)(ws + WS_WUP); bf16_t* Wout = (bf16_t*)(ws + WS_WOUT);
    bf16_t* Wgu = (bf16_t*)(ws + WS_WGU); bf16_t* Wdn = (bf16_t*)(ws + WS_WDN); bf16_t* Wlru = (bf16_t*)(ws + WS_WLRU);
    LAS float* lf = (LAS float*)lds;
    const int n0 = 16 * 43, n1 = 256, n2 = 16 * 44, n3 = 16 * 44, n4 = 44 * 16, ntot = n0 + n1 + n2 + n3 + n4;
    for (int t = lbid(); t < ntot; t += gridDim.x) {
        if (t < n0) transpose_tile(p->w_in + (size_t)l * DM * D_IN, DM, D_IN, Win, DM, 1, t, lf);
        else if (t < n0 + n1) transpose_tile(p->w_out + (size_t)l * DM * DM, DM, DM, Wout, DM, 0, t - n0, lf);
        else if (t < n0 + n1 + n2) transpose_tile(p->w_gate + (size_t)l * DM * FFN, DM, FFN, Wgu, DM, 2, t - n0 - n1, lf);
        else if (t < n0 + n1 + n2 + n3) transpose_tile(p->w_up + (size_t)l * DM * FFN, DM, FFN, Wgu, DM, 3, t - n0 - n1 - n2, lf);
        else transpose_tile(p->w_down + (size_t)l * FFN * DM, FFN, DM, Wdn, FFN, 0, t - n0 - n1 - n2 - n3, lf);
    }
    const int gtid = lbid() * NTHR + ltid(), gn = gridDim.x * NTHR;
    for (int i = gtid; i < 96 * DM; i += gn) Win[(size_t)416 * DM + i] = 0;
    const float* wuq = p->w_uq + (size_t)l * 256 * 384; const float* wukv = p->w_ukv + (size_t)l * 128 * 512;
    for (int i = gtid; i < 1024 * 384; i += gn) {
        const int n = i / 384, k = i % 384; float v = 0.f;
        if (n < 384) { if (k < 256) v = wuq[(size_t)k * 384 + n]; }
        else if (n < 896) { if (k >= 256) v = wukv[(size_t)(k - 256) * 512 + (n - 384)]; }
        Wup[i] = f2bf(v);
    }
    for (int i = gtid; i < 2 * 4 * 64 * 64; i += gn) {
        const int ty = i >> 14, n = (i >> 12) & 3, d = (i >> 6) & 63, c = i & 63;
        const float* w = (ty ? p->w_x : p->w_a) + (size_t)l * 4 * 64 * 64;
        Wlru[i] = f2bf(w[(n * 64 + c) * 64 + d]);
    }
    if (l == 0) {
        float* rt = (float*)(ws + WS_ROPE);
        for (int i = gtid; i < T * 16; i += gn) {
            const int row = i >> 4, j = i & 15;
            const float inv = powf(10000.0f, -(float)j / 16.0f);
            const float ang = (float)p->pos[row] * inv;
            float s, c; sincosf(ang, &s, &c);
            rt[2 * i] = c; rt[2 * i + 1] = s;
        }
    }
}

DI void phase_norm_cqkv(PP p, int l) {
    bf16_t* cq = (bf16_t*)(p->ws + WS_CQKV);
    const float* gq = p->q_norm_g + l * 256; const float* gk = p->kv_norm_g + l * 128;
    const int lane = ltid() & 63, wv = ltid() >> 6;
    for (int row = lbid() * 8 + wv; row < T; row += gridDim.x * 8) {
        bf16_t* r = cq + (size_t)row * 384;
        const u32x2 a = *(const u32x2*)(r + lane * 4); const unsigned b = *(const unsigned*)(r + 256 + lane * 2);
        const float a0 = bflo(a.x), a1 = bfhi(a.x), a2 = bflo(a.y), a3 = bfhi(a.y), b0 = bflo(b), b1 = bfhi(b);
        const float sq = wave_sum(a0 * a0 + a1 * a1 + a2 * a2 + a3 * a3), sk = wave_sum(b0 * b0 + b1 * b1);
        const float rq = rsqrtf(sq * (1.0f / 256) + NORM_EPS), rk = rsqrtf(sk * (1.0f / 128) + NORM_EPS);
        const f32x4 g4 = *(const f32x4*)(gq + lane * 4); const f32x2 g2 = *(const f32x2*)(gk + lane * 2);
        u32x2 o; o.x = cvt_pk_bf16(a0 * rq * g4[0], a1 * rq * g4[1]); o.y = cvt_pk_bf16(a2 * rq * g4[2], a3 * rq * g4[3]);
        *(u32x2*)(r + lane * 4) = o; *(unsigned*)(r + 256 + lane * 2) = cvt_pk_bf16(b0 * rk * g2[0], b1 * rk * g2[1]);
    }
}
DI void phase_group_norm(PP p, int l) {
    bf16_t* mix = (bf16_t*)(p->ws + WS_MIX);
    const int lane = ltid() & 63, wv = ltid() >> 6;
    for (int row = lbid() * 8 + wv; row < T; row += gridDim.x * 8) {
#pragma unroll
        for (int gi = 0; gi < 3; ++gi) {
            bf16_t* r = mix + (size_t)row * DM + gi * 256 + lane * 4;
            const u32x2 a = *(const u32x2*)r;
            const float a0 = bflo(a.x), a1 = bfhi(a.x), a2 = bflo(a.y), a3 = bfhi(a.y);
            const float ss = wave_sum(a0 * a0 + a1 * a1 + a2 * a2 + a3 * a3);
            const float rs = rsqrtf(ss * (1.0f / 256) + NORM_EPS);
            const f32x4 g4 = *(const f32x4*)(p->grp_g + (size_t)l * 768 + gi * 256 + lane * 4);
            u32x2 o; o.x = cvt_pk_bf16(a0 * rs * g4[0], a1 * rs * g4[1]); o.y = cvt_pk_bf16(a2 * rs * g4[2], a3 * rs * g4[3]);
            *(u32x2*)r = o;
        }
    }
}

DI void naive_mla(PP p, int item) {
    const bf16_t* qm = (const bf16_t*)(p->ws + WS_QM); const bf16_t* km = (const bf16_t*)(p->ws + WS_KM); const bf16_t* vm = (const bf16_t*)(p->ws + WS_VM);
    bf16_t* mix = (bf16_t*)(p->ws + WS_MIX);
    const int b = item >> 5, h = (item >> 3) & 3, qc = item & 7;
    const int t = qc * 512 + ltid();
    const size_t row = (size_t)b * SEQ + t;
    float q[96], o[64];
#pragma unroll
    for (int i = 0; i < 48; ++i) { const unsigned u = *(const unsigned*)(qm + row * 384 + h * 96 + 2 * i); q[2 * i] = bflo(u); q[2 * i + 1] = bfhi(u); }
#pragma unroll
    for (int i = 0; i < 64; ++i) o[i] = 0.f;
    float mx = -1e30f, l = 0.f;
    const int kend = __builtin_amdgcn_readfirstlane(qc * 512 + (ltid() | 63));
    const float scale = 0.10206207261596577f;
    for (int k = 0; k <= kend; ++k) {
        const unsigned* kr = (const unsigned*)(km + ((size_t)b * SEQ + k) * 384 + h * 96);
        const unsigned* vr = (const unsigned*)(vm + ((size_t)b * SEQ + k) * 256 + h * 64);
        float s = 0.f;
#pragma unroll
        for (int i = 0; i < 48; ++i) { const unsigned u = kr[i]; s += q[2 * i] * bflo(u) + q[2 * i + 1] * bfhi(u); }
        s *= scale;
        const bool valid = k <= t;
        const float mn = valid ? fmaxf(mx, s) : mx;
        const float alpha = __expf(mx - mn), pr = valid ? __expf(s - mn) : 0.f;
        l = l * alpha + pr; mx = mn;
#pragma unroll
        for (int i = 0; i < 32; ++i) { const unsigned u = vr[i]; o[2 * i] = o[2 * i] * alpha + pr * bflo(u); o[2 * i + 1] = o[2 * i + 1] * alpha + pr * bfhi(u); }
    }
    const float inv = 1.0f / l;
#pragma unroll
    for (int i = 0; i < 32; ++i) *(unsigned*)(mix + row * DM + h * 64 + 2 * i) = cvt_pk_bf16(o[2 * i] * inv, o[2 * i + 1] * inv);
}
DI void naive_sb(PP p, int item) {
    const bf16_t* P = (const bf16_t*)(p->ws + WS_P); bf16_t* mix = (bf16_t*)(p->ws + WS_MIX);
    const int b = item >> 5, h = (item >> 3) & 3, qc = item & 7;
    const int t = qc * 512 + ltid();
    const size_t row = (size_t)b * SEQ + t;
    float q[64], o[64];
#pragma unroll
    for (int i = 0; i < 32; ++i) { const unsigned u = *(const unsigned*)(P + row * PLD + P_SQ + h * 64 + 2 * i); q[2 * i] = bflo(u); q[2 * i + 1] = bfhi(u); }
#pragma unroll
    for (int i = 0; i < 64; ++i) o[i] = 0.f;
    float R = 0.f;
    const int kend = __builtin_amdgcn_readfirstlane(qc * 512 + (ltid() | 63));
    for (int k = kend - 1; k >= 0; --k) {
        const unsigned* kr = (const unsigned*)(P + ((size_t)b * SEQ + k) * PLD + P_SK + h * 64);
        const unsigned* vr = (const unsigned*)(P + ((size_t)b * SEQ + k) * PLD + P_SV + h * 64);
        float z = 0.f;
#pragma unroll
        for (int i = 0; i < 32; ++i) { const unsigned u = kr[i]; z += q[2 * i] * bflo(u) + q[2 * i + 1] * bfhi(u); }
        z *= 0.125f;
        const bool valid = k < t;
        const float lk = -(fmaxf(z, 0.f) + log1pf(__expf(-fabsf(z))));
        const float w = valid ? __expf(z + lk + R) : 0.f;
        R += valid ? lk : 0.f;
#pragma unroll
        for (int i = 0; i < 32; ++i) { const unsigned u = vr[i]; o[2 * i] += w * bflo(u); o[2 * i + 1] += w * bfhi(u); }
    }
#pragma unroll
    for (int i = 0; i < 32; ++i) *(unsigned*)(mix + row * DM + 512 + h * 64 + 2 * i) = cvt_pk_bf16(o[2 * i], o[2 * i + 1]);
}
DI void naive_lru_gates(PP p, int l, LAS unsigned char* lds) {
    const bf16_t* P = (const bf16_t*)(p->ws + WS_P);
    float* Aa = (float*)(p->ws + WS_U); float* Uu = Aa + (size_t)T * 256;
    LAS float* xs = (LAS float*)lds;
    const int tl = ltid() >> 8, ch = ltid() & 255, n = ch >> 6, d = ch & 63;
    const float* cw = p->conv_w + l * 4 * 256; const float cb = p->conv_b[l * 256 + ch];
    const float* wa = p->w_a + (size_t)l * 4 * 4096 + n * 4096; const float* wx = p->w_x + (size_t)l * 4 * 4096 + n * 4096;
    const float ba = p->b_a[l * 256 + ch], bx = p->b_x[l * 256 + ch];
    const float lam = p->lam[l * 256 + ch];
    const float sp = fmaxf(-lam, 0.f) + log1pf(__expf(-fabsf(lam)));
    for (int tile = lbid(); tile < T / 2; tile += gridDim.x) {
        const int row = tile * 2 + tl, s = row & (SEQ - 1);
        float xc = cb;
#pragma unroll
        for (int j = 0; j < 4; ++j) { const int ss = s - 3 + j; if (ss >= 0) xc += cw[j * 256 + ch] * bf2f(P[(size_t)(row - 3 + j) * PLD + P_LX + ch]); }
        xs[tl * 256 + ch] = xc;
        __syncthreads();
        float ra = ba, rx = bx;
#pragma unroll 4
        for (int c = 0; c < 64; ++c) { const float xv = xs[tl * 256 + n * 64 + c]; ra += xv * wa[c * 64 + d]; rx += xv * wx[c * 64 + d]; }
        const float la = -8.0f * sigmoidf_(ra) * sp;
        const float a = __expf(la);
        const float uu = sqrtf(fmaxf(-expm1f(2.0f * la), 0.f)) * sigmoidf_(rx) * xc;
        Aa[(size_t)row * 256 + ch] = a; Uu[(size_t)row * 256 + ch] = uu;
        __syncthreads();
    }
}
DI float gelu_tanh(float x) { const float u = 0.7978845608028654f * (x + 0.044715f * x * x * x); return 0.5f * x * (1.0f + tanhf(u)); }
DI void naive_lru_scan(PP p, int item) {
    const bf16_t* P = (const bf16_t*)(p->ws + WS_P); bf16_t* mix = (bf16_t*)(p->ws + WS_MIX);
    const float* Aa = (const float*)(p->ws + WS_U); const float* Uu = Aa + (size_t)T * 256;
    const int id = item * 512 + ltid(), b = id >> 8, ch = id & 255;
    float h = 0.f;
#pragma unroll 8
    for (int s = 0; s < SEQ; ++s) {
        const size_t row = (size_t)b * SEQ + s;
        h = Aa[row * 256 + ch] * h + Uu[row * 256 + ch];
        mix[row * DM + 256 + ch] = f2bf(h * gelu_tanh(bf2f(P[row * PLD + P_LG + ch])));
    }
}
DI float hg_lower_bound(PP p, int l, int c) {
    float v[DEPTH], mx = -1e30f, s = 0.f;
#pragma unroll
    for (int i = 0; i < DEPTH; ++i) { v[i] = p->lb_logits[i * 256 + c]; mx = fmaxf(mx, v[i]); }
#pragma unroll
    for (int i = 0; i < DEPTH; ++i) { v[i] = __expf(v[i] - mx); s += v[i]; }
    float lb = 0.f;
#pragma unroll
    for (int i = 1; i < DEPTH; ++i) if (i <= l) lb += v[i];
    return lb / s;
}
DI void naive_hgrn(PP p, int l, int item, LAS unsigned char* lds) {
    const bf16_t* P = (const bf16_t*)(p->ws + WS_P); bf16_t* mix = (bf16_t*)(p->ws + WS_MIX);
    LAS float* sf = (LAS float*)lds; LAS float* sk = sf + 128; LAS float* sq = sk + 128; LAS float* sv = sq + 128; LAS float* red = sv + 128;
    const int b = item >> 2, h = item & 3, tid = ltid(), e = tid & 63, dg = tid >> 6;
    const float lb = hg_lower_bound(p, l, h * 64 + e);
    const float ng = p->hg_norm_g[l * 256 + h * 64 + e];
    float st[8];
#pragma unroll
    for (int i = 0; i < 8; ++i) st[i] = 0.f;
    for (int s = 0; s < SEQ; ++s) {
        const size_t row = (size_t)b * SEQ + s; const int pb = (s & 1) * 64;
        if (tid < 64) {
            const float fz = bf2f(P[row * PLD + P_HF + h * 64 + e]);
            sf[pb + e] = fmaxf(lb, 1e-30f) + (1.0f - lb) * sigmoidf_(fz);
            sk[pb + e] = (1.0f - lb) * sigmoidf_(-fz);
            sq[pb + e] = bf2f(P[row * PLD + P_HQ + h * 64 + e]);
        } else if (tid < 128) sv[pb + e] = bf2f(P[row * PLD + P_HI + h * 64 + e]);
        __syncthreads();
        const float v = sv[pb + e]; float part = 0.f;
#pragma unroll
        for (int i = 0; i < 8; ++i) { const int d = dg * 8 + i; st[i] = sf[pb + d] * st[i] + sk[pb + d] * v; part += st[i] * sq[pb + d]; }
        red[(s & 1) * 512 + dg * 64 + e] = part;
        __syncthreads();
        if (tid < 64) {
            float o = 0.f;
#pragma unroll
            for (int i = 0; i < 8; ++i) o += red[(s & 1) * 512 + i * 64 + e];
            const float ss = wave_sum(o * o);
            const float rs = rsqrtf(ss * (1.0f / 64) + NORM_EPS);
            const float g = bf2f(P[row * PLD + P_HG + h * 64 + e]);
            mix[row * DM + 768 + h * 64 + e] = f2bf(o * rs * ng * g * sigmoidf_(g));
        }
    }
    __syncthreads();
}

constexpr int PH_PER_LAYER = 10, NSTEPS = DEPTH * PH_PER_LAYER + 1;
struct EpiAny {
    int kind; Epi1 e1; Epi2 e2; EpiRes er; EpiGU eg;
    DI void operator()(const Acc& acc, const pg8::Unit& u, int wr, int wc, int fr, int fq) const {
        switch (kind) { case 0: e1(acc, u, wr, wc, fr, fq); break; case 1: e2(acc, u, wr, wc, fr, fq); break; case 2: er(acc, u, wr, wc, fr, fq); break; default: eg(acc, u, wr, wc, fr, fq); break; }
    }
};

DI void run_step(PP p, int step, LAS unsigned char* lds) {
    unsigned char* ws = p->ws;
    const int l = step / PH_PER_LAYER, ph = step % PH_PER_LAYER;
    const float* hin = (l == 0) ? p->x : p->out;
    if (step == NSTEPS - 1) { rms_rows(p->out, p->fin_g, nullptr, p->out); return; }
    if (ph == 1 || ph == 3 || ph == 6 || ph == 8 || ph == 9) {
        pg8::Gemm g; EpiAny E;
        E.e1 = Epi1{(bf16_t*)(ws + WS_CQKV), (bf16_t*)(ws + WS_P), (bf16_t*)(ws + WS_KM), (const float*)(ws + WS_ROPE)};
        E.e2 = Epi2{(bf16_t*)(ws + WS_QM), (bf16_t*)(ws + WS_KM), (bf16_t*)(ws + WS_VM), (const float*)(ws + WS_ROPE)};
        E.er = EpiRes{ph == 6 ? hin : p->out, p->out};
        E.eg = EpiGU{(bf16_t*)(ws + WS_ACT)};
        if (ph == 1) { g = pg8::Gemm{(const bf16_t*)(ws + WS_U), (const bf16_t*)(ws + WS_WIN), T, NPROJ, DM}; E.kind = 0; }
        else if (ph == 3) { g = pg8::Gemm{(const bf16_t*)(ws + WS_CQKV), (const bf16_t*)(ws + WS_WUP), T, 1024, 384}; E.kind = 1; }
        else if (ph == 6) { g = pg8::Gemm{(const bf16_t*)(ws + WS_MIX), (const bf16_t*)(ws + WS_WOUT), T, DM, DM}; E.kind = 2; }
        else if (ph == 8) { g = pg8::Gemm{(const bf16_t*)(ws + WS_U), (const bf16_t*)(ws + WS_WGU), T, 2 * FFN, DM}; E.kind = 3; }
        else { g = pg8::Gemm{(const bf16_t*)(ws + WS_ACT), (const bf16_t*)(ws + WS_WDN), T, DM, FFN}; E.kind = 2; }
        pg8::StaticOrder S; S.init(g.M, g.N, gridDim.x, lbid());
        pg8::gemm_phase(lds, g, S, E);
        return;
    }
    switch (ph) {
    case 0: phase_convert(p, l, lds); rms_rows(hin, p->ln1_g + l * DM, (bf16_t*)(ws + WS_U), nullptr); break;
    case 2: phase_norm_cqkv(p, l); naive_lru_gates(p, l, lds); break;
    case 4: {
        for (int it = lbid(); it < 256 + 256 + 4 + 32; it += gridDim.x) {
            if (it < 256) naive_mla(p, it); else if (it < 512) naive_sb(p, it - 256); else if (it < 516) naive_lru_scan(p, it - 512); else naive_hgrn(p, l, it - 516, lds);
        } } break;
    case 5: phase_group_norm(p, l); break;
    case 7: rms_rows(p->out, p->ln2_g + l * DM, (bf16_t*)(ws + WS_U), nullptr); break;
    }
}

__global__ void __launch_bounds__(NTHR, 2) mega(Params p, int step_lo, int step_hi) {
    extern __shared__ __attribute__((aligned(16))) unsigned char lds_raw[];
    LAS unsigned char* lds = (LAS unsigned char*)lds_raw;
    for (int step = step_lo; step < step_hi; ++step) {
        PP pp = (PP)__builtin_amdgcn_kernarg_segment_ptr(); asm volatile("" : "+s"(pp));
        run_step(pp, step, lds);
        if (step + 1 < step_hi) { __threadfence(); cg::this_grid().sync(); }
    }
}

extern "C" void kernel_launch(void* const* d_in, const int* in_sizes, int n_in, void* d_out, int out_size, void* d_ws, size_t ws_size, hipStream_t stream) {
    static int inited = 0;
    if (!inited) {
        if (ws_size < WS_END) { fprintf(stderr, "kernel_launch: workspace too small: %zu < %zu\n", ws_size, (size_t)WS_END); return; }
        if (hipFuncSetAttribute((const void*)mega, hipFuncAttributeMaxDynamicSharedMemorySize, LDS_BYTES) != hipSuccess) { fprintf(stderr, "hipFuncSetAttribute failed\n"); return; }
        inited = 1;
    }
    Params p{};
    p.x = (const float*)d_in[0]; p.pos = (const int*)d_in[1]; p.ln1_g = (const float*)d_in[2]; p.w_in = (const float*)d_in[3]; p.q_norm_g = (const float*)d_in[4];
    p.w_uq = (const float*)d_in[5]; p.kv_norm_g = (const float*)d_in[6]; p.w_ukv = (const float*)d_in[7]; p.conv_w = (const float*)d_in[8]; p.conv_b = (const float*)d_in[9];
    p.w_a = (const float*)d_in[10]; p.b_a = (const float*)d_in[11]; p.w_x = (const float*)d_in[12]; p.b_x = (const float*)d_in[13]; p.lam = (const float*)d_in[14];
    p.lb_logits = (const float*)d_in[15]; p.hg_norm_g = (const float*)d_in[16]; p.grp_g = (const float*)d_in[17]; p.w_out = (const float*)d_in[18]; p.ln2_g = (const float*)d_in[19];
    p.w_gate = (const float*)d_in[20]; p.w_up = (const float*)d_in[21]; p.w_down = (const float*)d_in[22]; p.fin_g = (const float*)d_in[23];
    p.out = (float*)d_out; p.ws = (unsigned char*)d_ws;
    int lo = 0, hi = NSTEPS;
    void* args[] = {&p, &lo, &hi};
    hipError_t e = hipLaunchCooperativeKernel((const void*)mega, dim3(256), dim3(NTHR), args, LDS_BYTES, stream);
    if (e != hipSuccess) fprintf(stderr, "cooperative launch failed: %s\n", hipGetErrorString(e));
}
```

```cpp
#include <hip/hip_runtime.h>
#include <hip/hip_cooperative_groups.h>
#include <cstdio>
namespace cg = cooperative_groups;

#define LAS __attribute__((address_space(3)))
typedef unsigned short bf16_t;
typedef short bf16x8 __attribute__((ext_vector_type(8)));
typedef float f32x4 __attribute__((ext_vector_type(4)));
typedef float f32x2 __attribute__((ext_vector_type(2)));
typedef float f32x16 __attribute__((ext_vector_type(16)));
typedef unsigned u32x4 __attribute__((ext_vector_type(4)));
typedef unsigned u32x2 __attribute__((ext_vector_type(2)));

constexpr int BATCH = 8, SEQ = 4096, T = BATCH * SEQ, DM = 1024, DEPTH = 4;
constexpr int D_IN = 2720, NPROJ = 2816, FFN = 2816;
constexpr int PLD = 2304;
constexpr int P_LX = 0, P_LG = 256, P_SQ = 512, P_SK = 768, P_SV = 1024, P_HQ = 1280, P_HF = 1536, P_HI = 1792, P_HG = 2048;
constexpr int NTHR = 512, LDS_BYTES = 131072;
constexpr float NORM_EPS = 1e-6f;

constexpr size_t al256(size_t x) { return (x + 255) & ~(size_t)255; }
constexpr size_t WS_WIN = 0;
constexpr size_t WS_WUP = WS_WIN + al256((size_t)NPROJ * DM * 2);
constexpr size_t WS_WOUT = WS_WUP + al256((size_t)1024 * 384 * 2);
constexpr size_t WS_WGU = WS_WOUT + al256((size_t)DM * DM * 2);
constexpr size_t WS_WDN = WS_WGU + al256((size_t)2 * FFN * DM * 2);
constexpr size_t WS_WLRU = WS_WDN + al256((size_t)DM * FFN * 2);
constexpr size_t WS_ROPE = WS_WLRU + al256((size_t)2 * 4 * 64 * 64 * 2);
constexpr size_t WS_U = WS_ROPE + al256((size_t)T * 16 * 8);
constexpr size_t WS_MIX = WS_U + al256((size_t)T * DM * 2);
constexpr size_t WS_LAGG = WS_MIX + al256((size_t)T * DM * 2);
constexpr size_t WS_HDELTA = WS_LAGG + al256((size_t)BATCH * 64 * 256 * 8);
constexpr size_t WS_HDECAY = WS_HDELTA + al256((size_t)2048 * 4096 * 4);
constexpr size_t WS_HSTATE = WS_HDECAY + al256((size_t)2048 * 64 * 4);
constexpr size_t WS_BIG = WS_HSTATE + al256((size_t)2048 * 4096 * 2);
constexpr size_t WS_CQKV = WS_BIG;
constexpr size_t WS_P = WS_CQKV + al256((size_t)T * 384 * 2);
constexpr size_t WS_QM = WS_P + al256((size_t)T * PLD * 2);
constexpr size_t WS_KM = WS_QM + al256((size_t)T * 384 * 2);
constexpr size_t WS_VM = WS_KM + al256((size_t)T * 384 * 2);
constexpr size_t WS_SVT = WS_VM + al256((size_t)T * 256 * 2);
constexpr size_t WS_END1 = WS_SVT + al256((size_t)T * 256 * 2);
constexpr size_t WS_ACT = WS_BIG;
constexpr size_t WS_END2 = WS_ACT + al256((size_t)T * FFN * 2);
constexpr size_t WS_END = WS_END1 > WS_END2 ? WS_END1 : WS_END2;

struct Params {
    const float* x; const int* pos; const float* ln1_g; const float* w_in; const float* q_norm_g; const float* w_uq; const float* kv_norm_g; const float* w_ukv;
    const float* conv_w; const float* conv_b; const float* w_a; const float* b_a; const float* w_x; const float* b_x; const float* lam;
    const float* lb_logits; const float* hg_norm_g; const float* grp_g; const float* w_out; const float* ln2_g; const float* w_gate; const float* w_up; const float* w_down; const float* fin_g;
    float* out; unsigned char* ws;
};

#define DI __device__ __forceinline__
typedef const Params __attribute__((address_space(4)))* PP;
DI int ltid() { int t = threadIdx.x; asm volatile("" : "+v"(t)); return t; }
DI int lbid() { int b = blockIdx.x; asm volatile("" : "+s"(b)); return b; }
typedef __bf16 bf16x2_t __attribute__((ext_vector_type(2)));
DI unsigned cvt_pk_bf16(float lo, float hi) { f32x2 v = {lo, hi}; return __builtin_bit_cast(unsigned, __builtin_convertvector(v, bf16x2_t)); }
DI bf16_t f2bf(float f) { return (bf16_t)(cvt_pk_bf16(f, 0.f) & 0xffffu); }
DI float bf2f(bf16_t b) { return __uint_as_float(((unsigned)b) << 16); }
DI float bflo(unsigned u) { return __uint_as_float(u << 16); }
DI float bfhi(unsigned u) { return __uint_as_float(u & 0xffff0000u); }
DI float sigmoidf_(float x) { return 1.0f / (1.0f + __expf(-x)); }
DI float wave_sum(float v) { for (int o = 32; o > 0; o >>= 1) v += __shfl_xor(v, o); return v; }

namespace pg8 {
constexpr int BM = 256, BK = 64, HALF = 128, HTB = HALF * BK * 2, STAGE_BYTES = 8 * HTB, NXCD = 8, WGM = 8;
DI int lds_byte(int r, int c) { const int st = (r >> 4) * 2 + (c >> 5), rr = r & 15, cc = c & 31, ob = rr * 64 + cc * 2; return st * 1024 + (ob ^ (((ob >> 9) & 1) << 5)); }
DI void stage_rc(int b, int& R, int& C) { const int st = b / 1024, sb = b % 1024, swz = sb ^ (((sb >> 9) & 1) << 5); R = (st >> 1) * 16 + swz / 64; C = (st & 1) * 32 + (swz % 64) / 2; }
struct Unit { int pm, pn; };
struct Gemm { const bf16_t* A; const bf16_t* Bt; int M, N, K; };
struct StaticOrder {
    int nM, nN, nwg, G, c;
    DI void init(int M, int N, int G_, int c_) { nM = M / BM; nN = N / BM; nwg = nM * nN; G = G_; c = c_; }
    DI bool next(int i, Unit& u) const {
        const long L = (long)i * G + c; if (L >= nwg) return false;
        int wgid = (int)L; { const int q = nwg / NXCD, r = nwg % NXCD, xcd = wgid % NXCD, off = wgid / NXCD; wgid = (xcd < r ? xcd * (q + 1) : r * (q + 1) + (xcd - r) * q) + off; }
        const int nig = WGM * nN, gid = wgid / nig, fm = gid * WGM, gsz = (nM - fm) < WGM ? (nM - fm) : WGM;
        u.pm = fm + ((wgid % nig) % gsz); u.pn = (wgid % nig) / gsz; return true;
    }
};
template <class Epi>
DI void gemm_phase(LAS unsigned char* lds, const Gemm g, const StaticOrder& S, const Epi& E) {
    const int tid = ltid(), wid = __builtin_amdgcn_readfirstlane(tid >> 6), lane = tid & 63, wr = wid >> 2, wc = wid & 3, fr = lane & 15, fq = lane >> 4;
    const int K = g.K, nt = K / BK;
    unsigned voffA[2];
#pragma unroll
    for (int i = 0; i < 2; ++i) { int R, C; stage_rc(tid * 16 + i * 8192, R, C); voffA[i] = (unsigned)(R * K + C) * 2u; }
    const size_t kstep = (size_t)(BK * 2);
    const size_t hstep = (size_t)HALF * K * 2;
    const size_t tstep = 2 * hstep;
    const unsigned ldsw = (unsigned)wid * 1024u;
    const int aoff = lds_byte(wr * 64 + fr, fq * 8), boff = lds_byte(wc * 32 + fr, fq * 8);
#define PG8_SA(b, h) (((b) * 2 + (h)) * HTB)
#define PG8_SB(b, h) ((4 + (b) * 2 + (h)) * HTB)
#define PG8_STAGE(bufoff, gbase, voff) do { _Pragma("unroll") for (int _i = 0; _i < 2; ++_i) \
        __builtin_amdgcn_global_load_lds((const unsigned*)((const char*)(gbase) + (voff)[_i]), (LAS unsigned*)(lds + (bufoff) + ldsw + _i * 8192), 16, 0, 0); } while (0)
#define PG8_LDA(dst, b, h) do { _Pragma("unroll") for (int m = 0; m < 4; ++m) _Pragma("unroll") for (int k = 0; k < 2; ++k) dst[m][k] = *(const LAS bf16x8*)(lds + PG8_SA(b, h) + aoff + m * 2048 + k * 1024); } while (0)
#define PG8_LDB(dst, b, h) do { _Pragma("unroll") for (int n = 0; n < 2; ++n) _Pragma("unroll") for (int k = 0; k < 2; ++k) dst[n][k] = *(const LAS bf16x8*)(lds + PG8_SB(b, h) + boff + n * 2048 + k * 1024); } while (0)
#define PG8_MMA(ai, bj, At, Bt) do { __builtin_amdgcn_s_setprio(1); _Pragma("unroll") for (int m = 0; m < 4; ++m) _Pragma("unroll") for (int n = 0; n < 2; ++n) _Pragma("unroll") for (int k = 0; k < 2; ++k) \
        acc[ai][bj][m][n] = __builtin_amdgcn_mfma_f32_16x16x32_bf16(Bt[n][k], At[m][k], acc[ai][bj][m][n], 0, 0, 0); __builtin_amdgcn_s_setprio(0); } while (0)
#define PG8_WAIT_V(n) asm volatile("s_waitcnt vmcnt(" #n ")" ::: "memory")
#define PG8_WAIT_L(n) asm volatile("s_waitcnt lgkmcnt(" #n ")" ::: "memory")
#define PG8_BAR __builtin_amdgcn_s_barrier()
#define PG8_SCHED __builtin_amdgcn_sched_barrier(0)
    Unit cur, nxt; int ui = 0;
    if (!S.next(0, cur)) return;
    f32x4 acc[2][2][4][2];
#pragma unroll
    for (int a = 0; a < 2; ++a)
#pragma unroll
        for (int b = 0; b < 2; ++b)
#pragma unroll
            for (int m = 0; m < 4; ++m)
#pragma unroll
                for (int n = 0; n < 2; ++n) acc[a][b][m][n] = (f32x4){0.f, 0.f, 0.f, 0.f};
    bf16x8 At[4][2], B0[2][2], B1[2][2];
    const char* cA = (const char*)g.A + (size_t)cur.pm * tstep; const char* cB = (const char*)g.Bt + (size_t)cur.pn * tstep;
    PG8_STAGE(PG8_SB(0, 0), cB, voffA); PG8_STAGE(PG8_SA(0, 0), cA, voffA); PG8_STAGE(PG8_SB(0, 1), cB + hstep, voffA); PG8_STAGE(PG8_SA(0, 1), cA + hstep, voffA);
    if (wr == 1) PG8_BAR;
    PG8_WAIT_V(4); PG8_BAR;
    PG8_STAGE(PG8_SB(1, 0), cB + kstep, voffA); PG8_STAGE(PG8_SA(1, 0), cA + kstep, voffA); PG8_STAGE(PG8_SB(1, 1), cB + hstep + kstep, voffA);
    PG8_WAIT_V(6); PG8_BAR;
    for (;;) {
        const bool has_next = S.next(ui + 1, nxt);
        const char* nA = has_next ? (const char*)g.A + (size_t)nxt.pm * tstep : cA; const char* nB = has_next ? (const char*)g.Bt + (size_t)nxt.pn * tstep : cB;
        for (int t = 0; t < nt; t += 2) {
            const bool last = (t == nt - 2);
            const char* a1 = cA + (size_t)(t + 1) * kstep;
            const char* a2 = last ? nA : cA + (size_t)(t + 2) * kstep; const char* b2 = last ? nB : cB + (size_t)(t + 2) * kstep;
            const char* a3 = a2 + kstep; const char* b3 = b2 + kstep;
            PG8_LDB(B0, 0, 0); PG8_SCHED; PG8_LDA(At, 0, 0); PG8_STAGE(PG8_SA(1, 1), a1 + hstep, voffA);
            PG8_WAIT_L(8); PG8_BAR; PG8_WAIT_L(0); PG8_MMA(0, 0, At, B0); PG8_BAR; PG8_SCHED;
            PG8_LDB(B1, 0, 1); PG8_STAGE(PG8_SB(0, 0), b2, voffA);
            PG8_BAR; PG8_WAIT_L(0); PG8_MMA(0, 1, At, B1); PG8_BAR;
            PG8_LDA(At, 0, 1); PG8_STAGE(PG8_SA(0, 0), a2, voffA);
            PG8_BAR; PG8_WAIT_L(0); PG8_MMA(1, 0, At, B0); PG8_BAR; PG8_SCHED;
            PG8_STAGE(PG8_SB(0, 1), b2 + hstep, voffA);
            PG8_WAIT_V(6); PG8_BAR; PG8_MMA(1, 1, At, B1); PG8_BAR;
            PG8_LDB(B0, 1, 0); PG8_SCHED; PG8_LDA(At, 1, 0); PG8_STAGE(PG8_SA(0, 1), a2 + hstep, voffA);
            PG8_WAIT_L(8); PG8_BAR; PG8_WAIT_L(0); PG8_MMA(0, 0, At, B0); PG8_BAR; PG8_SCHED;
            PG8_LDB(B1, 1, 1); PG8_STAGE(PG8_SB(1, 0), b3, voffA);
            PG8_BAR; PG8_WAIT_L(0); PG8_MMA(0, 1, At, B1); PG8_BAR;
            PG8_LDA(At, 1, 1); PG8_STAGE(PG8_SA(1, 0), a3, voffA);
            PG8_BAR; PG8_WAIT_L(0); PG8_MMA(1, 0, At, B0); PG8_BAR; PG8_SCHED;
            PG8_STAGE(PG8_SB(1, 1), b3 + hstep, voffA);
            PG8_WAIT_V(6); PG8_BAR; PG8_MMA(1, 1, At, B1); PG8_BAR;
        }
        E(acc, cur, wr, wc, fr, fq);
        if (!has_next) break;
#pragma unroll
        for (int a = 0; a < 2; ++a)
#pragma unroll
            for (int b = 0; b < 2; ++b)
#pragma unroll
                for (int m = 0; m < 4; ++m)
#pragma unroll
                    for (int n = 0; n < 2; ++n) acc[a][b][m][n] = (f32x4){0.f, 0.f, 0.f, 0.f};
        cur = nxt; cA = nA; cB = nB; ++ui;
    }
    PG8_WAIT_V(0);
    if (wr == 0) PG8_BAR;
    PG8_BAR;
#undef PG8_SA
#undef PG8_SB
#undef PG8_STAGE
#undef PG8_LDA
#undef PG8_LDB
#undef PG8_MMA
#undef PG8_WAIT_V
#undef PG8_WAIT_L
#undef PG8_BAR
#undef PG8_SCHED
}
}

typedef f32x4 Acc[2][2][4][2];
DI void st_bf16x4(bf16_t* p, f32x4 v) { u32x2 w; w.x = cvt_pk_bf16(v[0], v[1]); w.y = cvt_pk_bf16(v[2], v[3]); *(u32x2*)p = w; }

struct Epi1 {
    bf16_t* cqkv; bf16_t* P; bf16_t* km; const float* rope; bf16_t* svt;
    DI void operator()(const Acc& acc, const pg8::Unit& u, int wr, int wc, int fr, int fq) const {
#pragma unroll
        for (int ai = 0; ai < 2; ++ai)
#pragma unroll
            for (int m = 0; m < 4; ++m) {
                const int row = u.pm * 256 + ai * 128 + wr * 64 + m * 16 + fr;
#pragma unroll
                for (int bj = 0; bj < 2; ++bj) {
                    const int c0 = u.pn * 256 + bj * 128 + wc * 32 + 4 * fq;
                    if (u.pn == 0 || (u.pn == 1 && bj == 0)) {
                        st_bf16x4(cqkv + (size_t)row * 384 + c0, acc[ai][bj][m][0]);
                        st_bf16x4(cqkv + (size_t)row * 384 + c0 + 16, acc[ai][bj][m][1]);
                    } else if (u.pn == 1) {
                        if (wc == 0) {
                            const f32x4 x1 = acc[ai][bj][m][0], x2 = acc[ai][bj][m][1];
                            const f32x4 cs0 = *(const f32x4*)(rope + (size_t)row * 32 + 8 * fq), cs1 = *(const f32x4*)(rope + (size_t)row * 32 + 8 * fq + 4);
                            f32x4 o1, o2;
                            o1[0] = x1[0] * cs0[0] - x2[0] * cs0[1]; o2[0] = x2[0] * cs0[0] + x1[0] * cs0[1];
                            o1[1] = x1[1] * cs0[2] - x2[1] * cs0[3]; o2[1] = x2[1] * cs0[2] + x1[1] * cs0[3];
                            o1[2] = x1[2] * cs1[0] - x2[2] * cs1[1]; o2[2] = x2[2] * cs1[0] + x1[2] * cs1[1];
                            o1[3] = x1[3] * cs1[2] - x2[3] * cs1[3]; o2[3] = x2[3] * cs1[2] + x1[3] * cs1[3];
#pragma unroll
                            for (int h = 0; h < 4; ++h) { st_bf16x4(km + (size_t)row * 384 + h * 96 + 64 + 4 * fq, o1); st_bf16x4(km + (size_t)row * 384 + h * 96 + 80 + 4 * fq, o2); }
                        }
                    } else if (u.pn == 6) {
                        const int cv = bj * 128 + wc * 32 + 4 * fq;
                        bf16_t* d = svt + ((size_t)(row >> 12) * 256 + cv) * SEQ + (row & (SEQ - 1));
#pragma unroll
                        for (int j = 0; j < 4; ++j) { d[(size_t)j * SEQ] = f2bf(acc[ai][bj][m][0][j]); d[(size_t)(j + 16) * SEQ] = f2bf(acc[ai][bj][m][1][j]); }
                        st_bf16x4(P + (size_t)row * PLD + (c0 - 512), acc[ai][bj][m][0]);
                        st_bf16x4(P + (size_t)row * PLD + (c0 - 512) + 16, acc[ai][bj][m][1]);
                    } else {
                        st_bf16x4(P + (size_t)row * PLD + (c0 - 512), acc[ai][bj][m][0]);
                        st_bf16x4(P + (size_t)row * PLD + (c0 - 512) + 16, acc[ai][bj][m][1]);
                    }
                }
            }
    }
};
struct Epi2 {
    bf16_t* qm; bf16_t* km; bf16_t* vm; const float* rope;
    DI void operator()(const Acc& acc, const pg8::Unit& u, int wr, int wc, int fr, int fq) const {
#pragma unroll
        for (int ai = 0; ai < 2; ++ai)
#pragma unroll
            for (int m = 0; m < 4; ++m) {
                const int row = u.pm * 256 + ai * 128 + wr * 64 + m * 16 + fr;
#pragma unroll
                for (int bj = 0; bj < 2; ++bj) {
                    const int grp = u.pn * 8 + bj * 4 + wc;
                    const f32x4 x1 = acc[ai][bj][m][0], x2 = acc[ai][bj][m][1];
                    if (grp < 12) {
                        bf16_t* d = qm + (size_t)row * 384 + grp * 32 + 4 * fq;
                        if (grp % 3 == 2) {
                            const f32x4 cs0 = *(const f32x4*)(rope + (size_t)row * 32 + 8 * fq), cs1 = *(const f32x4*)(rope + (size_t)row * 32 + 8 * fq + 4);
                            f32x4 o1, o2;
                            o1[0] = x1[0] * cs0[0] - x2[0] * cs0[1]; o2[0] = x2[0] * cs0[0] + x1[0] * cs0[1];
                            o1[1] = x1[1] * cs0[2] - x2[1] * cs0[3]; o2[1] = x2[1] * cs0[2] + x1[1] * cs0[3];
                            o1[2] = x1[2] * cs1[0] - x2[2] * cs1[1]; o2[2] = x2[2] * cs1[0] + x1[2] * cs1[1];
                            o1[3] = x1[3] * cs1[2] - x2[3] * cs1[3]; o2[3] = x2[3] * cs1[2] + x1[3] * cs1[3];
                            st_bf16x4(d, o1); st_bf16x4(d + 16, o2);
                        } else { st_bf16x4(d, x1); st_bf16x4(d + 16, x2); }
                    } else if (grp < 28) {
                        const int g2 = grp - 12, head = g2 >> 2, sub = g2 & 3;
                        if (sub < 2) { bf16_t* d = km + (size_t)row * 384 + head * 96 + sub * 32 + 4 * fq; st_bf16x4(d, x1); st_bf16x4(d + 16, x2); }
                        else {
                            bf16_t* d = vm + ((size_t)(row >> 12) * 256 + head * 64 + (sub - 2) * 32 + 4 * fq) * SEQ + (row & (SEQ - 1));
#pragma unroll
                            for (int j = 0; j < 4; ++j) { d[(size_t)j * SEQ] = f2bf(x1[j]); d[(size_t)(j + 16) * SEQ] = f2bf(x2[j]); }
                        }
                    }
                }
            }
    }
};
struct EpiRes {
    const float* hin; float* hout;
    DI void operator()(const Acc& acc, const pg8::Unit& u, int wr, int wc, int fr, int fq) const {
#pragma unroll
        for (int ai = 0; ai < 2; ++ai)
#pragma unroll
            for (int m = 0; m < 4; ++m) {
                const size_t off = (size_t)(u.pm * 256 + ai * 128 + wr * 64 + m * 16 + fr) * DM + u.pn * 256 + wc * 32 + 4 * fq;
#pragma unroll
                for (int bj = 0; bj < 2; ++bj)
#pragma unroll
                    for (int n = 0; n < 2; ++n) { const f32x4 b = *(const f32x4*)(hin + off + bj * 128 + n * 16); *(f32x4*)(hout + off + bj * 128 + n * 16) = b + acc[ai][bj][m][n]; }
            }
    }
};
struct EpiGU {
    bf16_t* act;
    DI void operator()(const Acc& acc, const pg8::Unit& u, int wr, int wc, int fr, int fq) const {
#pragma unroll
        for (int ai = 0; ai < 2; ++ai)
#pragma unroll
            for (int m = 0; m < 4; ++m) {
                const int row = u.pm * 256 + ai * 128 + wr * 64 + m * 16 + fr;
#pragma unroll
                for (int bj = 0; bj < 2; ++bj) {
                    const int grp = u.pn * 8 + bj * 4 + wc;
                    const f32x4 g = acc[ai][bj][m][0], up = acc[ai][bj][m][1];
                    f32x4 o;
#pragma unroll
                    for (int j = 0; j < 4; ++j) o[j] = g[j] * sigmoidf_(g[j]) * up[j];
                    st_bf16x4(act + (size_t)row * FFN + grp * 16 + 4 * fq, o);
                }
            }
    }
};

DI int rowmap(int mode, int n) { return mode == 0 ? n : mode == 1 ? (n < 416 ? n : n + 96) : mode == 2 ? (32 * (n >> 4) + (n & 15)) : (32 * (n >> 4) + 16 + (n & 15)); }
DI void transpose_tile(const float* W, int K, int N, bf16_t* dst, int ldd, int mode, int tile, LAS float* lds) {
    const int ntn = (N + 63) / 64, kt = tile / ntn, nt = tile % ntn, k0 = kt * 64, n0 = nt * 64, tid = ltid();
#pragma unroll
    for (int i = 0; i < 8; ++i) { const int idx = tid + i * NTHR, r = idx >> 6, c = idx & 63; lds[r * 65 + c] = (n0 + c < N) ? W[(size_t)(k0 + r) * N + n0 + c] : 0.f; }
    __syncthreads();
#pragma unroll
    for (int i = 0; i < 8; ++i) { const int idx = tid + i * NTHR, rr = idx >> 6, cc = idx & 63; if (n0 + rr < N) dst[(size_t)rowmap(mode, n0 + rr) * ldd + k0 + cc] = f2bf(lds[cc * 65 + rr]); }
    __syncthreads();
}
DI void rms_rows(const float* src, const float* g, bf16_t* dst, float* dstf) {
    const int lane = ltid() & 63, wv = ltid() >> 6;
    for (int row = lbid() * 8 + wv; row < T; row += gridDim.x * 8) {
        const float* s = src + (size_t)row * DM;
        f32x4 v[4]; float ss = 0.f;
#pragma unroll
        for (int i = 0; i < 4; ++i) { v[i] = *(const f32x4*)(s + i * 256 + lane * 4); ss += v[i][0] * v[i][0] + v[i][1] * v[i][1] + v[i][2] * v[i][2] + v[i][3] * v[i][3]; }
        ss = wave_sum(ss);
        const float rs = rsqrtf(ss * (1.0f / DM) + NORM_EPS);
#pragma unroll
        for (int i = 0; i < 4; ++i) { const f32x4 gg = *(const f32x4*)(g + i * 256 + lane * 4); f32x4 o = v[i] * rs * gg;
            if (dst) st_bf16x4(dst + (size_t)row * DM + i * 256 + lane * 4, o); else *(f32x4*)(dstf + (size_t)row * DM + i * 256 + lane * 4) = o; }
    }
}

DI void phase_convert(PP p, int l, LAS unsigned char* lds) {
    unsigned char* ws = p->ws;
    bf16_t* Win = (bf16_t*)(ws + WS_WIN); bf16_t* Wup = (bf16_t*)(ws + WS_WUP); bf16_t* Wout = (bf16_t*)(ws + WS_WOUT);
    bf16_t* Wgu = (bf16_t*)(ws + WS_WGU); bf16_t* Wdn = (bf16_t*)(ws + WS_WDN); bf16_t* Wlru = (bf16_t*)(ws + WS_WLRU);
    LAS float* lf = (LAS float*)lds;
    const int n0 = 16 * 43, n1 = 256, n2 = 16 * 44, n3 = 16 * 44, n4 = 44 * 16, ntot = n0 + n1 + n2 + n3 + n4;
    for (int t = lbid(); t < ntot; t += gridDim.x) {
        if (t < n0) transpose_tile(p->w_in + (size_t)l * DM * D_IN, DM, D_IN, Win, DM, 1, t, lf);
        else if (t < n0 + n1) transpose_tile(p->w_out + (size_t)l * DM * DM, DM, DM, Wout, DM, 0, t - n0, lf);
        else if (t < n0 + n1 + n2) transpose_tile(p->w_gate + (size_t)l * DM * FFN, DM, FFN, Wgu, DM, 2, t - n0 - n1, lf);
        else if (t < n0 + n1 + n2 + n3) transpose_tile(p->w_up + (size_t)l * DM * FFN, DM, FFN, Wgu, DM, 3, t - n0 - n1 - n2, lf);
        else transpose_tile(p->w_down + (size_t)l * FFN * DM, FFN, DM, Wdn, FFN, 0, t - n0 - n1 - n2 - n3, lf);
    }
    const int gtid = lbid() * NTHR + ltid(), gn = gridDim.x * NTHR;
    for (int i = gtid; i < 96 * DM; i += gn) Win[(size_t)416 * DM + i] = 0;
    const float* wuq = p->w_uq + (size_t)l * 256 * 384; const float* wukv = p->w_ukv + (size_t)l * 128 * 512;
    for (int i = gtid; i < 1024 * 384; i += gn) {
        const int n = i / 384, k = i % 384; float v = 0.f;
        if (n < 384) { if (k < 256) v = wuq[(size_t)k * 384 + n]; }
        else if (n < 896) { if (k >= 256) v = wukv[(size_t)(k - 256) * 512 + (n - 384)]; }
        Wup[i] = f2bf(v);
    }
    for (int i = gtid; i < 2 * 4 * 64 * 64; i += gn) {
        const int ty = i >> 14, n = (i >> 12) & 3, d = (i >> 6) & 63, c = i & 63;
        const float* w = (ty ? p->w_x : p->w_a) + (size_t)l * 4 * 64 * 64;
        Wlru[i] = f2bf(w[(n * 64 + c) * 64 + d]);
    }
    if (l == 0) {
        float* rt = (float*)(ws + WS_ROPE);
        for (int i = gtid; i < T * 16; i += gn) {
            const int row = i >> 4, j = i & 15;
            const float inv = powf(10000.0f, -(float)j / 16.0f);
            const float ang = (float)p->pos[row] * inv;
            float s, c; sincosf(ang, &s, &c);
            rt[2 * i] = c; rt[2 * i + 1] = s;
        }
    }
}

DI void phase_norm_cqkv(PP p, int l) {
    bf16_t* cq = (bf16_t*)(p->ws + WS_CQKV);
    const float* gq = p->q_norm_g + l * 256; const float* gk = p->kv_norm_g + l * 128;
    const int lane = ltid() & 63, wv = ltid() >> 6;
    for (int row = lbid() * 8 + wv; row < T; row += gridDim.x * 8) {
        bf16_t* r = cq + (size_t)row * 384;
        const u32x2 a = *(const u32x2*)(r + lane * 4); const unsigned b = *(const unsigned*)(r + 256 + lane * 2);
        const float a0 = bflo(a.x), a1 = bfhi(a.x), a2 = bflo(a.y), a3 = bfhi(a.y), b0 = bflo(b), b1 = bfhi(b);
        const float sq = wave_sum(a0 * a0 + a1 * a1 + a2 * a2 + a3 * a3), sk = wave_sum(b0 * b0 + b1 * b1);
        const float rq = rsqrtf(sq * (1.0f / 256) + NORM_EPS), rk = rsqrtf(sk * (1.0f / 128) + NORM_EPS);
        const f32x4 g4 = *(const f32x4*)(gq + lane * 4); const f32x2 g2 = *(const f32x2*)(gk + lane * 2);
        u32x2 o; o.x = cvt_pk_bf16(a0 * rq * g4[0], a1 * rq * g4[1]); o.y = cvt_pk_bf16(a2 * rq * g4[2], a3 * rq * g4[3]);
        *(u32x2*)(r + lane * 4) = o; *(unsigned*)(r + 256 + lane * 2) = cvt_pk_bf16(b0 * rk * g2[0], b1 * rk * g2[1]);
    }
}
DI void phase_group_norm(PP p, int l) {
    bf16_t* mix = (bf16_t*)(p->ws + WS_MIX);
    const int lane = ltid() & 63, wv = ltid() >> 6;
    for (int row = lbid() * 8 + wv; row < T; row += gridDim.x * 8) {
#pragma unroll
        for (int gi = 0; gi < 3; ++gi) {
            bf16_t* r = mix + (size_t)row * DM + gi * 256 + lane * 4;
            const u32x2 a = *(const u32x2*)r;
            const float a0 = bflo(a.x), a1 = bfhi(a.x), a2 = bflo(a.y), a3 = bfhi(a.y);
            const float ss = wave_sum(a0 * a0 + a1 * a1 + a2 * a2 + a3 * a3);
            const float rs = rsqrtf(ss * (1.0f / 256) + NORM_EPS);
            const f32x4 g4 = *(const f32x4*)(p->grp_g + (size_t)l * 768 + gi * 256 + lane * 4);
            u32x2 o; o.x = cvt_pk_bf16(a0 * rs * g4[0], a1 * rs * g4[1]); o.y = cvt_pk_bf16(a2 * rs * g4[2], a3 * rs * g4[3]);
            *(u32x2*)r = o;
        }
    }
}

DI void naive_mla(PP p, int item) {
    const bf16_t* qm = (const bf16_t*)(p->ws + WS_QM); const bf16_t* km = (const bf16_t*)(p->ws + WS_KM); const bf16_t* vm = (const bf16_t*)(p->ws + WS_VM);
    bf16_t* mix = (bf16_t*)(p->ws + WS_MIX);
    const int b = item >> 5, h = (item >> 3) & 3, qc = item & 7;
    const int t = qc * 512 + ltid();
    const size_t row = (size_t)b * SEQ + t;
    float q[96], o[64];
#pragma unroll
    for (int i = 0; i < 48; ++i) { const unsigned u = *(const unsigned*)(qm + row * 384 + h * 96 + 2 * i); q[2 * i] = bflo(u); q[2 * i + 1] = bfhi(u); }
#pragma unroll
    for (int i = 0; i < 64; ++i) o[i] = 0.f;
    float mx = -1e30f, l = 0.f;
    const int kend = __builtin_amdgcn_readfirstlane(qc * 512 + (ltid() | 63));
    const float scale = 0.10206207261596577f;
    for (int k = 0; k <= kend; ++k) {
        const unsigned* kr = (const unsigned*)(km + ((size_t)b * SEQ + k) * 384 + h * 96);
        const unsigned* vr = (const unsigned*)(vm + ((size_t)b * SEQ + k) * 256 + h * 64);
        float s = 0.f;
#pragma unroll
        for (int i = 0; i < 48; ++i) { const unsigned u = kr[i]; s += q[2 * i] * bflo(u) + q[2 * i + 1] * bfhi(u); }
        s *= scale;
        const bool valid = k <= t;
        const float mn = valid ? fmaxf(mx, s) : mx;
        const float alpha = __expf(mx - mn), pr = valid ? __expf(s - mn) : 0.f;
        l = l * alpha + pr; mx = mn;
#pragma unroll
        for (int i = 0; i < 32; ++i) { const unsigned u = vr[i]; o[2 * i] = o[2 * i] * alpha + pr * bflo(u); o[2 * i + 1] = o[2 * i + 1] * alpha + pr * bfhi(u); }
    }
    const float inv = 1.0f / l;
#pragma unroll
    for (int i = 0; i < 32; ++i) *(unsigned*)(mix + row * DM + h * 64 + 2 * i) = cvt_pk_bf16(o[2 * i] * inv, o[2 * i + 1] * inv);
}
DI void naive_sb(PP p, int item) {
    const bf16_t* P = (const bf16_t*)(p->ws + WS_P); bf16_t* mix = (bf16_t*)(p->ws + WS_MIX);
    const int b = item >> 5, h = (item >> 3) & 3, qc = item & 7;
    const int t = qc * 512 + ltid();
    const size_t row = (size_t)b * SEQ + t;
    float q[64], o[64];
#pragma unroll
    for (int i = 0; i < 32; ++i) { const unsigned u = *(const unsigned*)(P + row * PLD + P_SQ + h * 64 + 2 * i); q[2 * i] = bflo(u); q[2 * i + 1] = bfhi(u); }
#pragma unroll
    for (int i = 0; i < 64; ++i) o[i] = 0.f;
    float R = 0.f;
    const int kend = __builtin_amdgcn_readfirstlane(qc * 512 + (ltid() | 63));
    for (int k = kend - 1; k >= 0; --k) {
        const unsigned* kr = (const unsigned*)(P + ((size_t)b * SEQ + k) * PLD + P_SK + h * 64);
        const unsigned* vr = (const unsigned*)(P + ((size_t)b * SEQ + k) * PLD + P_SV + h * 64);
        float z = 0.f;
#pragma unroll
        for (int i = 0; i < 32; ++i) { const unsigned u = kr[i]; z += q[2 * i] * bflo(u) + q[2 * i + 1] * bfhi(u); }
        z *= 0.125f;
        const bool valid = k < t;
        const float lk = -(fmaxf(z, 0.f) + log1pf(__expf(-fabsf(z))));
        const float w = valid ? __expf(z + lk + R) : 0.f;
        R += valid ? lk : 0.f;
#pragma unroll
        for (int i = 0; i < 32; ++i) { const unsigned u = vr[i]; o[2 * i] += w * bflo(u); o[2 * i + 1] += w * bfhi(u); }
    }
#pragma unroll
    for (int i = 0; i < 32; ++i) *(unsigned*)(mix + row * DM + 512 + h * 64 + 2 * i) = cvt_pk_bf16(o[2 * i], o[2 * i + 1]);
}
DI void naive_lru_gates(PP p, int l, LAS unsigned char* lds) {
    const bf16_t* P = (const bf16_t*)(p->ws + WS_P);
    float* Aa = (float*)(p->ws + WS_U); float* Uu = Aa + (size_t)T * 256;
    LAS float* xs = (LAS float*)lds;
    const int tl = ltid() >> 8, ch = ltid() & 255, n = ch >> 6, d = ch & 63;
    const float* cw = p->conv_w + l * 4 * 256; const float cb = p->conv_b[l * 256 + ch];
    const float* wa = p->w_a + (size_t)l * 4 * 4096 + n * 4096; const float* wx = p->w_x + (size_t)l * 4 * 4096 + n * 4096;
    const float ba = p->b_a[l * 256 + ch], bx = p->b_x[l * 256 + ch];
    const float lam = p->lam[l * 256 + ch];
    const float sp = fmaxf(-lam, 0.f) + log1pf(__expf(-fabsf(lam)));
    for (int tile = lbid(); tile < T / 2; tile += gridDim.x) {
        const int row = tile * 2 + tl, s = row & (SEQ - 1);
        float xc = cb;
#pragma unroll
        for (int j = 0; j < 4; ++j) { const int ss = s - 3 + j; if (ss >= 0) xc += cw[j * 256 + ch] * bf2f(P[(size_t)(row - 3 + j) * PLD + P_LX + ch]); }
        xs[tl * 256 + ch] = xc;
        __syncthreads();
        float ra = ba, rx = bx;
#pragma unroll 4
        for (int c = 0; c < 64; ++c) { const float xv = xs[tl * 256 + n * 64 + c]; ra += xv * wa[c * 64 + d]; rx += xv * wx[c * 64 + d]; }
        const float la = -8.0f * sigmoidf_(ra) * sp;
        const float a = __expf(la);
        const float uu = sqrtf(fmaxf(-expm1f(2.0f * la), 0.f)) * sigmoidf_(rx) * xc;
        Aa[(size_t)row * 256 + ch] = a; Uu[(size_t)row * 256 + ch] = uu;
        __syncthreads();
    }
}
DI float gelu_tanh(float x) { const float u = 0.7978845608028654f * (x + 0.044715f * x * x * x); return 0.5f * x * (1.0f + tanhf(u)); }
DI void naive_lru_scan(PP p, int item) {
    const bf16_t* P = (const bf16_t*)(p->ws + WS_P); bf16_t* mix = (bf16_t*)(p->ws + WS_MIX);
    const float* Aa = (const float*)(p->ws + WS_U); const float* Uu = Aa + (size_t)T * 256;
    const int id = item * 512 + ltid(), b = id >> 8, ch = id & 255;
    float h = 0.f;
#pragma unroll 8
    for (int s = 0; s < SEQ; ++s) {
        const size_t row = (size_t)b * SEQ + s;
        h = Aa[row * 256 + ch] * h + Uu[row * 256 + ch];
        mix[row * DM + 256 + ch] = f2bf(h * gelu_tanh(bf2f(P[row * PLD + P_LG + ch])));
    }
}
DI float hg_lower_bound(PP p, int l, int c) {
    float v[DEPTH], mx = -1e30f, s = 0.f;
#pragma unroll
    for (int i = 0; i < DEPTH; ++i) { v[i] = p->lb_logits[i * 256 + c]; mx = fmaxf(mx, v[i]); }
#pragma unroll
    for (int i = 0; i < DEPTH; ++i) { v[i] = __expf(v[i] - mx); s += v[i]; }
    float lb = 0.f;
#pragma unroll
    for (int i = 1; i < DEPTH; ++i) if (i <= l) lb += v[i];
    return lb / s;
}
DI void naive_hgrn(PP p, int l, int item, LAS unsigned char* lds) {
    const bf16_t* P = (const bf16_t*)(p->ws + WS_P); bf16_t* mix = (bf16_t*)(p->ws + WS_MIX);
    LAS float* sf = (LAS float*)lds; LAS float* sk = sf + 128; LAS float* sq = sk + 128; LAS float* sv = sq + 128; LAS float* red = sv + 128;
    const int b = item >> 2, h = item & 3, tid = ltid(), e = tid & 63, dg = tid >> 6;
    const float lb = hg_lower_bound(p, l, h * 64 + e);
    const float ng = p->hg_norm_g[l * 256 + h * 64 + e];
    float st[8];
#pragma unroll
    for (int i = 0; i < 8; ++i) st[i] = 0.f;
    for (int s = 0; s < SEQ; ++s) {
        const size_t row = (size_t)b * SEQ + s; const int pb = (s & 1) * 64;
        if (tid < 64) {
            const float fz = bf2f(P[row * PLD + P_HF + h * 64 + e]);
            sf[pb + e] = fmaxf(lb, 1e-30f) + (1.0f - lb) * sigmoidf_(fz);
            sk[pb + e] = (1.0f - lb) * sigmoidf_(-fz);
            sq[pb + e] = bf2f(P[row * PLD + P_HQ + h * 64 + e]);
        } else if (tid < 128) sv[pb + e] = bf2f(P[row * PLD + P_HI + h * 64 + e]);
        __syncthreads();
        const float v = sv[pb + e]; float part = 0.f;
#pragma unroll
        for (int i = 0; i < 8; ++i) { const int d = dg * 8 + i; st[i] = sf[pb + d] * st[i] + sk[pb + d] * v; part += st[i] * sq[pb + d]; }
        red[(s & 1) * 512 + dg * 64 + e] = part;
        __syncthreads();
        if (tid < 64) {
            float o = 0.f;
#pragma unroll
            for (int i = 0; i < 8; ++i) o += red[(s & 1) * 512 + i * 64 + e];
            const float ss = wave_sum(o * o);
            const float rs = rsqrtf(ss * (1.0f / 64) + NORM_EPS);
            const float g = bf2f(P[row * PLD + P_HG + h * 64 + e]);
            mix[row * DM + 768 + h * 64 + e] = f2bf(o * rs * ng * g * sigmoidf_(g));
        }
    }
    __syncthreads();
}


#define MFMA32(a, b, c) __builtin_amdgcn_mfma_f32_32x32x16_bf16((a), (b), (c), 0, 0, 0)
DI bf16x8 pack8(const f32x16& x, int base) {
    u32x4 r; r.x = cvt_pk_bf16(x[base], x[base + 1]); r.y = cvt_pk_bf16(x[base + 2], x[base + 3]); r.z = cvt_pk_bf16(x[base + 4], x[base + 5]); r.w = cvt_pk_bf16(x[base + 6], x[base + 7]);
    return __builtin_bit_cast(bf16x8, r);
}
template <bool SB>
DI void attn_item(PP p, int b, int h, int qb, LAS unsigned char* lds) {
    constexpr int DK = SB ? 64 : 96, NKS = DK / 16;
    constexpr int KSTR = DK * 2 + 16, VSTR = 144, KBYTES = 64 * KSTR, VBYTES = 64 * VSTR, BUF = KBYTES + VBYTES;
    constexpr int KCH = DK / 8;
    const int tid = ltid(), lane = tid & 63, w = __builtin_amdgcn_readfirstlane(tid >> 6), ql = lane & 31, g = lane >> 5;
    unsigned char* ws = p->ws;
    const size_t rowb = (size_t)b * SEQ;
    const bf16_t* Qg = SB ? (const bf16_t*)(ws + WS_P) + P_SQ + h * 64 : (const bf16_t*)(ws + WS_QM) + h * 96;
    const bf16_t* Kg = SB ? (const bf16_t*)(ws + WS_P) + P_SK + h * 64 : (const bf16_t*)(ws + WS_KM) + h * 96;
    const bf16_t* VTg = (const bf16_t*)(ws + (SB ? WS_SVT : WS_VM)) + (size_t)(b * 4 + h) * 64 * SEQ;
    constexpr int QLD = SB ? PLD : 384;
    const int q0 = qb * 256 + w * 32, myq = q0 + ql;
    bf16x8 qf[NKS];
#pragma unroll
    for (int ks = 0; ks < NKS; ++ks) qf[ks] = *(const bf16x8*)(Qg + (rowb + myq) * QLD + ks * 16 + g * 8);
    f32x16 o[2];
#pragma unroll
    for (int i = 0; i < 16; ++i) { o[0][i] = 0.f; o[1][i] = 0.f; }
    float m_run = -1e30f, lsum = 0.f, R = 0.f;
    bf16x8 Mlo, Mhi, Mone;
    if (SB) {
#pragma unroll
        for (int jj = 0; jj < 8; ++jj) { const int j = 8 * (jj >> 2) + 4 * g + (jj & 3); Mlo[jj] = (j > ql) ? (short)0x3F80 : (short)0; Mhi[jj] = (j + 16 > ql) ? (short)0x3F80 : (short)0; Mone[jj] = (short)0x3F80; }
    }
    const int ntiles = (qb + 1) * 4;
    const int kkey0 = SB ? (tid >> 3) : (tid / 12), kpart0 = SB ? (tid & 7) : (tid % 12);
    const int kkey1 = (tid + 512) / 12, kpart1 = (tid + 512) % 12;
    const int vdv = tid >> 3, vpart = tid & 7;
    u32x4 rk0, rk1, rv;
    rk1 = (u32x4){0u, 0u, 0u, 0u};
#define ATT_LOAD(kt) do { const size_t kr = rowb + (size_t)(kt) * 64; \
        rk0 = *(const u32x4*)(Kg + (kr + kkey0) * QLD + kpart0 * 8); \
        if (!SB && tid < 256) rk1 = *(const u32x4*)(Kg + (kr + kkey1) * QLD + kpart1 * 8); \
        rv = *(const u32x4*)(VTg + (size_t)vdv * SEQ + (size_t)(kt) * 64 + vpart * 8); } while (0)
#define ATT_WRITE(bufi) do { LAS unsigned char* kb_ = lds + (bufi) * BUF; \
        *(LAS u32x4*)(kb_ + kkey0 * KSTR + kpart0 * 16) = rk0; \
        if (!SB && tid < 256) *(LAS u32x4*)(kb_ + kkey1 * KSTR + kpart1 * 16) = rk1; \
        *(LAS u32x4*)(kb_ + KBYTES + vdv * VSTR + vpart * 16) = rv; } while (0)
    { const int kt0 = SB ? ntiles - 1 : 0; ATT_LOAD(kt0); ATT_WRITE(0); }
    __syncthreads();
    for (int it = 0; it < ntiles; ++it) {
        const int kt = SB ? ntiles - 1 - it : it;
        if (it + 1 < ntiles) { const int ktn = SB ? kt - 1 : kt + 1; ATT_LOAD(ktn); }
        const int key0 = kt * 64;
        if (key0 <= q0 + 31) {
            LAS unsigned char* kb = lds + (it & 1) * BUF; LAS unsigned char* vb = kb + KBYTES;
            f32x16 s[2];
#pragma unroll
            for (int i = 0; i < 16; ++i) { s[0][i] = 0.f; s[1][i] = 0.f; }
#pragma unroll
            for (int rt = 0; rt < 2; ++rt)
#pragma unroll
                for (int ks = 0; ks < NKS; ++ks) { const bf16x8 kf = *(const LAS bf16x8*)(kb + (32 * rt + ql) * KSTR + (ks * 16 + g * 8) * 2); s[rt] = MFMA32(kf, qf[ks], s[rt]); }
            const bool domask = (key0 + 63 >= q0);
            bf16x8 pf[4];
            if (!SB) {
                const float sc = 0.10206207261596577f * 1.4426950408889634f;
                float mx = m_run;
#pragma unroll
                for (int rt = 0; rt < 2; ++rt)
#pragma unroll
                    for (int i = 0; i < 16; ++i) { float v = s[rt][i] * sc; const int key = key0 + 32 * rt + 8 * (i >> 2) + 4 * g + (i & 3); if (domask && key > myq) v = -1e30f; s[rt][i] = v; mx = fmaxf(mx, v); }
                mx = fmaxf(mx, __shfl_xor(mx, 32));
                const float alpha = __builtin_amdgcn_exp2f(m_run - mx); m_run = mx;
                float ps = 0.f;
#pragma unroll
                for (int rt = 0; rt < 2; ++rt)
#pragma unroll
                    for (int i = 0; i < 16; ++i) { const float pv = __builtin_amdgcn_exp2f(s[rt][i] - mx); s[rt][i] = pv; ps += pv; }
                lsum = lsum * alpha + ps;
#pragma unroll
                for (int i = 0; i < 16; ++i) { o[0][i] *= alpha; o[1][i] *= alpha; }
            } else {
                const float sc = 0.125f * 1.4426950408889634f;
                f32x16 lk[2]; float lks = 0.f;
#pragma unroll
                for (int rt = 0; rt < 2; ++rt)
#pragma unroll
                    for (int i = 0; i < 16; ++i) {
                        const float z2 = s[rt][i] * sc; const int key = key0 + 32 * rt + 8 * (i >> 2) + 4 * g + (i & 3);
                        const float e = __builtin_amdgcn_exp2f(-fabsf(z2));
                        float l2 = -(fmaxf(z2, 0.f) + __builtin_amdgcn_logf(1.0f + e));
                        const bool valid = !domask || key < myq;
                        l2 = valid ? l2 : 0.f;
                        lk[rt][i] = l2; lks += l2; s[rt][i] = valid ? z2 + l2 : -1e30f;
                    }
                bf16x8 lf[4];
#pragma unroll
                for (int ks = 0; ks < 4; ++ks) lf[ks] = pack8(lk[ks >> 1], 8 * (ks & 1));
                f32x16 lat0, lat1;
#pragma unroll
                for (int i = 0; i < 16; ++i) { lat0[i] = R; lat1[i] = R; }
                lat0 = MFMA32(Mlo, lf[0], lat0); lat0 = MFMA32(Mhi, lf[1], lat0); lat0 = MFMA32(Mone, lf[2], lat0); lat0 = MFMA32(Mone, lf[3], lat0);
                lat1 = MFMA32(Mlo, lf[2], lat1); lat1 = MFMA32(Mhi, lf[3], lat1);
#pragma unroll
                for (int i = 0; i < 16; ++i) { s[0][i] = __builtin_amdgcn_exp2f(s[0][i] + lat0[i]); s[1][i] = __builtin_amdgcn_exp2f(s[1][i] + lat1[i]); }
                lks += __shfl_xor(lks, 32);
                R += lks;
            }
#pragma unroll
            for (int ks = 0; ks < 4; ++ks) pf[ks] = pack8(s[ks >> 1], 8 * (ks & 1));
#pragma unroll
            for (int dvt = 0; dvt < 2; ++dvt)
#pragma unroll
                for (int ks = 0; ks < 4; ++ks) {
                    const u32x2 lo = *(const LAS u32x2*)(vb + (32 * dvt + ql) * VSTR + (16 * ks + 4 * g) * 2);
                    const u32x2 hi = *(const LAS u32x2*)(vb + (32 * dvt + ql) * VSTR + (16 * ks + 8 + 4 * g) * 2);
                    u32x4 vv; vv.x = lo.x; vv.y = lo.y; vv.z = hi.x; vv.w = hi.y;
                    o[dvt] = MFMA32(__builtin_bit_cast(bf16x8, vv), pf[ks], o[dvt]);
                }
        }
        if (it + 1 < ntiles) ATT_WRITE((it + 1) & 1);
        __syncthreads();
    }
#undef ATT_LOAD
#undef ATT_WRITE
    float inv = 1.0f;
    if (!SB) { const float lt = lsum + __shfl_xor(lsum, 32); inv = 1.0f / lt; }
    bf16_t* dst = (bf16_t*)(ws + WS_MIX) + (rowb + myq) * DM + (SB ? 512 : 0) + h * 64 + 4 * g;
#pragma unroll
    for (int dvt = 0; dvt < 2; ++dvt)
#pragma unroll
        for (int k4 = 0; k4 < 4; ++k4) {
            f32x4 v; v[0] = o[dvt][4 * k4] * inv; v[1] = o[dvt][4 * k4 + 1] * inv; v[2] = o[dvt][4 * k4 + 2] * inv; v[3] = o[dvt][4 * k4 + 3] * inv;
            st_bf16x4(dst + 32 * dvt + 8 * k4, v);
        }
}
#define DBG_SB_NAIVE 0
DI void attn_phase_items(PP p, LAS unsigned char* lds) {
    const int c = lbid(), G = gridDim.x;
    for (int r = 0; r * G < 1024; ++r) {
        const int L = r * G + ((r & 1) ? (G - 1 - c) : c);
        if (L >= 1024) continue;
        const int qb = 15 - (L >> 6), sub = L & 63, bh = sub & 31;
        if (sub < 32) { if (DBG_SB_NAIVE == 0) attn_item<true>(p, bh >> 2, bh & 3, qb, lds); } else attn_item<false>(p, bh >> 2, bh & 3, qb, lds);
    }
}

constexpr int PH_PER_LAYER = 10, NSTEPS = DEPTH * PH_PER_LAYER + 1;
struct EpiAny {
    int kind; void* a0; void* a1; void* a2; void* a3; void* a4;
    DI void operator()(const Acc& acc, const pg8::Unit& u, int wr, int wc, int fr, int fq) const {
        asm volatile("" : "+v"(fr), "+v"(fq));
        switch (kind) {
        case 0: { Epi1 e{(bf16_t*)a0, (bf16_t*)a1, (bf16_t*)a2, (const float*)a3, (bf16_t*)a4}; e(acc, u, wr, wc, fr, fq); } break;
        case 1: { Epi2 e{(bf16_t*)a0, (bf16_t*)a1, (bf16_t*)a2, (const float*)a3}; e(acc, u, wr, wc, fr, fq); } break;
        case 2: { EpiRes e{(const float*)a0, (float*)a1}; e(acc, u, wr, wc, fr, fq); } break;
        default: { EpiGU e{(bf16_t*)a0}; e(acc, u, wr, wc, fr, fq); } break;
        }
    }
};

DI void run_step(PP p, int step, LAS unsigned char* lds) {
    unsigned char* ws = p->ws;
    const int l = step / PH_PER_LAYER, ph = step % PH_PER_LAYER;
    const float* hin = (l == 0) ? p->x : p->out;
    if (step == NSTEPS - 1) { rms_rows(p->out, p->fin_g, nullptr, p->out); return; }
    if (ph == 1 || ph == 3 || ph == 6 || ph == 8 || ph == 9) {
        pg8::Gemm g; EpiAny E;
        if (ph == 1) { g = pg8::Gemm{(const bf16_t*)(ws + WS_U), (const bf16_t*)(ws + WS_WIN), T, NPROJ, DM}; E = EpiAny{0, ws + WS_CQKV, ws + WS_P, ws + WS_KM, ws + WS_ROPE, ws + WS_SVT}; }
        else if (ph == 3) { g = pg8::Gemm{(const bf16_t*)(ws + WS_CQKV), (const bf16_t*)(ws + WS_WUP), T, 1024, 384}; E = EpiAny{1, ws + WS_QM, ws + WS_KM, ws + WS_VM, ws + WS_ROPE, nullptr}; }
        else if (ph == 6) { g = pg8::Gemm{(const bf16_t*)(ws + WS_MIX), (const bf16_t*)(ws + WS_WOUT), T, DM, DM}; E = EpiAny{2, (void*)hin, p->out, nullptr, nullptr, nullptr}; }
        else if (ph == 8) { g = pg8::Gemm{(const bf16_t*)(ws + WS_U), (const bf16_t*)(ws + WS_WGU), T, 2 * FFN, DM}; E = EpiAny{3, ws + WS_ACT, nullptr, nullptr, nullptr, nullptr}; }
        else { g = pg8::Gemm{(const bf16_t*)(ws + WS_ACT), (const bf16_t*)(ws + WS_WDN), T, DM, FFN}; E = EpiAny{2, p->out, p->out, nullptr, nullptr, nullptr}; }
        pg8::StaticOrder S; S.init(g.M, g.N, gridDim.x, lbid());
        pg8::gemm_phase(lds, g, S, E);
        return;
    }
    switch (ph) {
    case 0: phase_convert(p, l, lds); rms_rows(hin, p->ln1_g + l * DM, (bf16_t*)(ws + WS_U), nullptr); break;
    case 2: phase_norm_cqkv(p, l); naive_lru_gates(p, l, lds); break;
    case 4: {
        attn_phase_items(p, lds);
        if (DBG_SB_NAIVE) naive_sb(p, lbid());
        for (int it = lbid(); it < 4 + 32; it += gridDim.x) { if (it < 4) naive_lru_scan(p, it); else naive_hgrn(p, l, it - 4, lds); }
        } break;
    case 5: phase_group_norm(p, l); break;
    case 7: rms_rows(p->out, p->ln2_g + l * DM, (bf16_t*)(ws + WS_U), nullptr); break;
    }
}

__global__ void __launch_bounds__(NTHR, 2) mega(Params p, int step_lo, int step_hi) {
    extern __shared__ __attribute__((aligned(16))) unsigned char lds_raw[];
    LAS unsigned char* lds = (LAS unsigned char*)lds_raw;
    for (int step = step_lo; step < step_hi; ++step) {
        PP pp = (PP)__builtin_amdgcn_kernarg_segment_ptr(); asm volatile("" : "+s"(pp));
        run_step(pp, step, lds);
        if (step + 1 < step_hi) { __threadfence(); cg::this_grid().sync(); }
    }
}

extern "C" void kernel_launch(void* const* d_in, const int* in_sizes, int n_in, void* d_out, int out_size, void* d_ws, size_t ws_size, hipStream_t stream) {
    static int inited = 0;
    if (!inited) {
        if (ws_size < WS_END) { fprintf(stderr, "kernel_launch: workspace too small: %zu < %zu\n", ws_size, (size_t)WS_END); return; }
        if (hipFuncSetAttribute((const void*)mega, hipFuncAttributeMaxDynamicSharedMemorySize, LDS_BYTES) != hipSuccess) { fprintf(stderr, "hipFuncSetAttribute failed\n"); return; }
        inited = 1;
    }
    Params p{};
    p.x = (const float*)d_in[0]; p.pos = (const int*)d_in[1]; p.ln1_g = (const float*)d_in[2]; p.w_in = (const float*)d_in[3]; p.q_norm_g = (const float*)d_in[4];
    p.w_uq = (const float*)d_in[5]; p.kv_norm_g = (const float*)d_in[6]; p.w_ukv = (const float*)d_in[7]; p.conv_w = (const float*)d_in[8]; p.conv_b = (const float*)d_in[9];
    p.w_a = (const float*)d_in[10]; p.b_a = (const float*)d_in[11]; p.w_x = (const float*)d_in[12]; p.b_x = (const float*)d_in[13]; p.lam = (const float*)d_in[14];
    p.lb_logits = (const float*)d_in[15]; p.hg_norm_g = (const float*)d_in[16]; p.grp_g = (const float*)d_in[17]; p.w_out = (const float*)d_in[18]; p.ln2_g = (const float*)d_in[19];
    p.w_gate = (const float*)d_in[20]; p.w_up = (const float*)d_in[21]; p.w_down = (const float*)d_in[22]; p.fin_g = (const float*)d_in[23];
    p.out = (float*)d_out; p.ws = (unsigned char*)d_ws;
    int lo = 0, hi = NSTEPS;
    void* args[] = {&p, &lo, &hi};
    hipError_t e = hipLaunchCooperativeKernel((const void*)mega, dim3(256), dim3(NTHR), args, LDS_BYTES, stream);
    if (e != hipSuccess) fprintf(stderr, "cooperative launch failed: %s\n", hipGetErrorString(e));
}
```

```cpp
#include <hip/hip_runtime.h>
#include <hip/hip_cooperative_groups.h>
#include <cstdio>
namespace cg = cooperative_groups;

#define LAS __attribute__((address_space(3)))
typedef unsigned short bf16_t;
typedef short bf16x8 __attribute__((ext_vector_type(8)));
typedef float f32x4 __attribute__((ext_vector_type(4)));
typedef float f32x2 __attribute__((ext_vector_type(2)));
typedef float f32x16 __attribute__((ext_vector_type(16)));
typedef unsigned u32x4 __attribute__((ext_vector_type(4)));
typedef unsigned u32x2 __attribute__((ext_vector_type(2)));

constexpr int BATCH = 8, SEQ = 4096, T = BATCH * SEQ, DM = 1024, DEPTH = 4;
constexpr int D_IN = 2720, NPROJ = 2816, FFN = 2816;
constexpr int PLD = 2304;
constexpr int P_LX = 0, P_LG = 256, P_SQ = 512, P_SK = 768, P_SV = 1024, P_HQ = 1280, P_HF = 1536, P_HI = 1792, P_HG = 2048;
constexpr int NTHR = 512, LDS_BYTES = 131072;
constexpr float NORM_EPS = 1e-6f;

constexpr size_t al256(size_t x) { return (x + 255) & ~(size_t)255; }
constexpr size_t WS_WIN = 0;
constexpr size_t WS_WUP = WS_WIN + al256((size_t)NPROJ * DM * 2);
constexpr size_t WS_WOUT = WS_WUP + al256((size_t)1024 * 384 * 2);
constexpr size_t WS_WGU = WS_WOUT + al256((size_t)DM * DM * 2);
constexpr size_t WS_WDN = WS_WGU + al256((size_t)2 * FFN * DM * 2);
constexpr size_t WS_WLRU = WS_WDN + al256((size_t)DM * FFN * 2);
constexpr size_t WS_ROPE = WS_WLRU + al256((size_t)2 * 4 * 64 * 64 * 2);
constexpr size_t WS_U = WS_ROPE + al256((size_t)T * 16 * 8);
constexpr size_t WS_MIX = WS_U + al256((size_t)T * DM * 2);
constexpr size_t WS_LAGG = WS_MIX + al256((size_t)T * DM * 2);
constexpr size_t WS_HDELTA = WS_LAGG + al256((size_t)BATCH * 64 * 256 * 8);
constexpr size_t WS_HDECAY = WS_HDELTA + al256((size_t)2048 * 4096 * 4);
constexpr size_t WS_HSTATE = WS_HDECAY + al256((size_t)2048 * 64 * 4);
constexpr size_t WS_BIG = WS_HSTATE + al256((size_t)2048 * 4096 * 2);
constexpr size_t WS_CQKV = WS_BIG;
constexpr size_t WS_P = WS_CQKV + al256((size_t)T * 384 * 2);
constexpr size_t WS_QM = WS_P + al256((size_t)T * PLD * 2);
constexpr size_t WS_KM = WS_QM + al256((size_t)T * 384 * 2);
constexpr size_t WS_VM = WS_KM + al256((size_t)T * 384 * 2);
constexpr size_t WS_SVT = WS_VM + al256((size_t)T * 256 * 2);
constexpr size_t WS_END1 = WS_SVT + al256((size_t)T * 256 * 2);
constexpr size_t WS_ACT = WS_BIG;
constexpr size_t WS_END2 = WS_ACT + al256((size_t)T * FFN * 2);
constexpr size_t WS_END = WS_END1 > WS_END2 ? WS_END1 : WS_END2;

struct Params {
    const float* x; const int* pos; const float* ln1_g; const float* w_in; const float* q_norm_g; const float* w_uq; const float* kv_norm_g; const float* w_ukv;
    const float* conv_w; const float* conv_b; const float* w_a; const float* b_a; const float* w_x; const float* b_x; const float* lam;
    const float* lb_logits; const float* hg_norm_g; const float* grp_g; const float* w_out; const float* ln2_g; const float* w_gate; const float* w_up; const float* w_down; const float* fin_g;
    float* out; unsigned char* ws;
};

#define DI __device__ __forceinline__
typedef const Params __attribute__((address_space(4)))* PP;
DI int ltid() { int t = threadIdx.x; asm volatile("" : "+v"(t)); return t; }
DI int lbid() { int b = blockIdx.x; asm volatile("" : "+s"(b)); return b; }
typedef __bf16 bf16x2_t __attribute__((ext_vector_type(2)));
DI unsigned cvt_pk_bf16(float lo, float hi) { f32x2 v = {lo, hi}; return __builtin_bit_cast(unsigned, __builtin_convertvector(v, bf16x2_t)); }
DI bf16_t f2bf(float f) { return (bf16_t)(cvt_pk_bf16(f, 0.f) & 0xffffu); }
DI float bf2f(bf16_t b) { return __uint_as_float(((unsigned)b) << 16); }
DI float bflo(unsigned u) { return __uint_as_float(u << 16); }
DI float bfhi(unsigned u) { return __uint_as_float(u & 0xffff0000u); }
DI float sigmoidf_(float x) { return 1.0f / (1.0f + __expf(-x)); }
DI float wave_sum(float v) { for (int o = 32; o > 0; o >>= 1) v += __shfl_xor(v, o); return v; }

namespace pg8 {
constexpr int BM = 256, BK = 64, HALF = 128, HTB = HALF * BK * 2, STAGE_BYTES = 8 * HTB, NXCD = 8, WGM = 8;
DI int lds_byte(int r, int c) { const int st = (r >> 4) * 2 + (c >> 5), rr = r & 15, cc = c & 31, ob = rr * 64 + cc * 2; return st * 1024 + (ob ^ (((ob >> 9) & 1) << 5)); }
DI void stage_rc(int b, int& R, int& C) { const int st = b / 1024, sb = b % 1024, swz = sb ^ (((sb >> 9) & 1) << 5); R = (st >> 1) * 16 + swz / 64; C = (st & 1) * 32 + (swz % 64) / 2; }
struct Unit { int pm, pn; };
struct Gemm { const bf16_t* A; const bf16_t* Bt; int M, N, K; };
struct StaticOrder {
    int nM, nN, nwg, G, c;
    DI void init(int M, int N, int G_, int c_) { nM = M / BM; nN = N / BM; nwg = nM * nN; G = G_; c = c_; }
    DI bool next(int i, Unit& u) const {
        const long L = (long)i * G + c; if (L >= nwg) return false;
        int wgid = (int)L; { const int q = nwg / NXCD, r = nwg % NXCD, xcd = wgid % NXCD, off = wgid / NXCD; wgid = (xcd < r ? xcd * (q + 1) : r * (q + 1) + (xcd - r) * q) + off; }
        const int nig = WGM * nN, gid = wgid / nig, fm = gid * WGM, gsz = (nM - fm) < WGM ? (nM - fm) : WGM;
        u.pm = fm + ((wgid % nig) % gsz); u.pn = (wgid % nig) / gsz; return true;
    }
};
template <class Epi>
DI void gemm_phase(LAS unsigned char* lds, const Gemm g, const StaticOrder& S, const Epi& E) {
    const int tid = ltid(), wid = __builtin_amdgcn_readfirstlane(tid >> 6), lane = tid & 63, wr = wid >> 2, wc = wid & 3, fr = lane & 15, fq = lane >> 4;
    const int K = g.K, nt = K / BK;
    unsigned voffA[2];
#pragma unroll
    for (int i = 0; i < 2; ++i) { int R, C; stage_rc(tid * 16 + i * 8192, R, C); voffA[i] = (unsigned)(R * K + C) * 2u; }
    const size_t kstep = (size_t)(BK * 2);
    const size_t hstep = (size_t)HALF * K * 2;
    const size_t tstep = 2 * hstep;
    const unsigned ldsw = (unsigned)wid * 1024u;
    const int aoff = lds_byte(wr * 64 + fr, fq * 8), boff = lds_byte(wc * 32 + fr, fq * 8);
#define PG8_SA(b, h) (((b) * 2 + (h)) * HTB)
#define PG8_SB(b, h) ((4 + (b) * 2 + (h)) * HTB)
#define PG8_STAGE(bufoff, gbase, voff) do { _Pragma("unroll") for (int _i = 0; _i < 2; ++_i) \
        __builtin_amdgcn_global_load_lds((const unsigned*)((const char*)(gbase) + (voff)[_i]), (LAS unsigned*)(lds + (bufoff) + ldsw + _i * 8192), 16, 0, 0); } while (0)
#define PG8_LDA(dst, b, h) do { _Pragma("unroll") for (int m = 0; m < 4; ++m) _Pragma("unroll") for (int k = 0; k < 2; ++k) dst[m][k] = *(const LAS bf16x8*)(lds + PG8_SA(b, h) + aoff + m * 2048 + k * 1024); } while (0)
#define PG8_LDB(dst, b, h) do { _Pragma("unroll") for (int n = 0; n < 2; ++n) _Pragma("unroll") for (int k = 0; k < 2; ++k) dst[n][k] = *(const LAS bf16x8*)(lds + PG8_SB(b, h) + boff + n * 2048 + k * 1024); } while (0)
#define PG8_MMA(ai, bj, At, Bt) do { __builtin_amdgcn_s_setprio(1); _Pragma("unroll") for (int m = 0; m < 4; ++m) _Pragma("unroll") for (int n = 0; n < 2; ++n) _Pragma("unroll") for (int k = 0; k < 2; ++k) \
        acc[ai][bj][m][n] = __builtin_amdgcn_mfma_f32_16x16x32_bf16(Bt[n][k], At[m][k], acc[ai][bj][m][n], 0, 0, 0); __builtin_amdgcn_s_setprio(0); } while (0)
#define PG8_WAIT_V(n) asm volatile("s_waitcnt vmcnt(" #n ")" ::: "memory")
#define PG8_WAIT_L(n) asm volatile("s_waitcnt lgkmcnt(" #n ")" ::: "memory")
#define PG8_BAR __builtin_amdgcn_s_barrier()
#define PG8_SCHED __builtin_amdgcn_sched_barrier(0)
    Unit cur, nxt; int ui = 0;
    if (!S.next(0, cur)) return;
    f32x4 acc[2][2][4][2];
#pragma unroll
    for (int a = 0; a < 2; ++a)
#pragma unroll
        for (int b = 0; b < 2; ++b)
#pragma unroll
            for (int m = 0; m < 4; ++m)
#pragma unroll
                for (int n = 0; n < 2; ++n) acc[a][b][m][n] = (f32x4){0.f, 0.f, 0.f, 0.f};
    bf16x8 At[4][2], B0[2][2], B1[2][2];
    const char* cA = (const char*)g.A + (size_t)cur.pm * tstep; const char* cB = (const char*)g.Bt + (size_t)cur.pn * tstep;
    PG8_STAGE(PG8_SB(0, 0), cB, voffA); PG8_STAGE(PG8_SA(0, 0), cA, voffA); PG8_STAGE(PG8_SB(0, 1), cB + hstep, voffA); PG8_STAGE(PG8_SA(0, 1), cA + hstep, voffA);
    if (wr == 1) PG8_BAR;
    PG8_WAIT_V(4); PG8_BAR;
    PG8_STAGE(PG8_SB(1, 0), cB + kstep, voffA); PG8_STAGE(PG8_SA(1, 0), cA + kstep, voffA); PG8_STAGE(PG8_SB(1, 1), cB + hstep + kstep, voffA);
    PG8_WAIT_V(6); PG8_BAR;
    for (;;) {
        const bool has_next = S.next(ui + 1, nxt);
        const char* nA = has_next ? (const char*)g.A + (size_t)nxt.pm * tstep : cA; const char* nB = has_next ? (const char*)g.Bt + (size_t)nxt.pn * tstep : cB;
        for (int t = 0; t < nt; t += 2) {
            const bool last = (t == nt - 2);
            const char* a1 = cA + (size_t)(t + 1) * kstep;
            const char* a2 = last ? nA : cA + (size_t)(t + 2) * kstep; const char* b2 = last ? nB : cB + (size_t)(t + 2) * kstep;
            const char* a3 = a2 + kstep; const char* b3 = b2 + kstep;
            PG8_LDB(B0, 0, 0); PG8_SCHED; PG8_LDA(At, 0, 0); PG8_STAGE(PG8_SA(1, 1), a1 + hstep, voffA);
            PG8_WAIT_L(8); PG8_BAR; PG8_WAIT_L(0); PG8_MMA(0, 0, At, B0); PG8_BAR; PG8_SCHED;
            PG8_LDB(B1, 0, 1); PG8_STAGE(PG8_SB(0, 0), b2, voffA);
            PG8_BAR; PG8_WAIT_L(0); PG8_MMA(0, 1, At, B1); PG8_BAR;
            PG8_LDA(At, 0, 1); PG8_STAGE(PG8_SA(0, 0), a2, voffA);
            PG8_BAR; PG8_WAIT_L(0); PG8_MMA(1, 0, At, B0); PG8_BAR; PG8_SCHED;
            PG8_STAGE(PG8_SB(0, 1), b2 + hstep, voffA);
            PG8_WAIT_V(6); PG8_BAR; PG8_MMA(1, 1, At, B1); PG8_BAR;
            PG8_LDB(B0, 1, 0); PG8_SCHED; PG8_LDA(At, 1, 0); PG8_STAGE(PG8_SA(0, 1), a2 + hstep, voffA);
            PG8_WAIT_L(8); PG8_BAR; PG8_WAIT_L(0); PG8_MMA(0, 0, At, B0); PG8_BAR; PG8_SCHED;
            PG8_LDB(B1, 1, 1); PG8_STAGE(PG8_SB(1, 0), b3, voffA);
            PG8_BAR; PG8_WAIT_L(0); PG8_MMA(0, 1, At, B1); PG8_BAR;
            PG8_LDA(At, 1, 1); PG8_STAGE(PG8_SA(1, 0), a3, voffA);
            PG8_BAR; PG8_WAIT_L(0); PG8_MMA(1, 0, At, B0); PG8_BAR; PG8_SCHED;
            PG8_STAGE(PG8_SB(1, 1), b3 + hstep, voffA);
            PG8_WAIT_V(6); PG8_BAR; PG8_MMA(1, 1, At, B1); PG8_BAR;
        }
        E(acc, cur, wr, wc, fr, fq);
        if (!has_next) break;
#pragma unroll
        for (int a = 0; a < 2; ++a)
#pragma unroll
            for (int b = 0; b < 2; ++b)
#pragma unroll
                for (int m = 0; m < 4; ++m)
#pragma unroll
                    for (int n = 0; n < 2; ++n) acc[a][b][m][n] = (f32x4){0.f, 0.f, 0.f, 0.f};
        cur = nxt; cA = nA; cB = nB; ++ui;
    }
    PG8_WAIT_V(0);
    if (wr == 0) PG8_BAR;
    PG8_BAR;
#undef PG8_SA
#undef PG8_SB
#undef PG8_STAGE
#undef PG8_LDA
#undef PG8_LDB
#undef PG8_MMA
#undef PG8_WAIT_V
#undef PG8_WAIT_L
#undef PG8_BAR
#undef PG8_SCHED
}
}

typedef f32x4 Acc[2][2][4][2];
DI void st_bf16x4(bf16_t* p, f32x4 v) { u32x2 w; w.x = cvt_pk_bf16(v[0], v[1]); w.y = cvt_pk_bf16(v[2], v[3]); *(u32x2*)p = w; }

struct Epi1 {
    bf16_t* cqkv; bf16_t* P; bf16_t* km; const float* rope; bf16_t* svt;
    DI void operator()(const Acc& acc, const pg8::Unit& u, int wr, int wc, int fr, int fq) const {
#pragma unroll
        for (int ai = 0; ai < 2; ++ai)
#pragma unroll
            for (int m = 0; m < 4; ++m) {
                const int row = u.pm * 256 + ai * 128 + wr * 64 + m * 16 + fr;
#pragma unroll
                for (int bj = 0; bj < 2; ++bj) {
                    const int c0 = u.pn * 256 + bj * 128 + wc * 32 + 4 * fq;
                    if (u.pn == 0 || (u.pn == 1 && bj == 0)) {
                        st_bf16x4(cqkv + (size_t)row * 384 + c0, acc[ai][bj][m][0]);
                        st_bf16x4(cqkv + (size_t)row * 384 + c0 + 16, acc[ai][bj][m][1]);
                    } else if (u.pn == 1) {
                        if (wc == 0) {
                            const f32x4 x1 = acc[ai][bj][m][0], x2 = acc[ai][bj][m][1];
                            const f32x4 cs0 = *(const f32x4*)(rope + (size_t)row * 32 + 8 * fq), cs1 = *(const f32x4*)(rope + (size_t)row * 32 + 8 * fq + 4);
                            f32x4 o1, o2;
                            o1[0] = x1[0] * cs0[0] - x2[0] * cs0[1]; o2[0] = x2[0] * cs0[0] + x1[0] * cs0[1];
                            o1[1] = x1[1] * cs0[2] - x2[1] * cs0[3]; o2[1] = x2[1] * cs0[2] + x1[1] * cs0[3];
                            o1[2] = x1[2] * cs1[0] - x2[2] * cs1[1]; o2[2] = x2[2] * cs1[0] + x1[2] * cs1[1];
                            o1[3] = x1[3] * cs1[2] - x2[3] * cs1[3]; o2[3] = x2[3] * cs1[2] + x1[3] * cs1[3];
#pragma unroll
                            for (int h = 0; h < 4; ++h) { st_bf16x4(km + (size_t)row * 384 + h * 96 + 64 + 4 * fq, o1); st_bf16x4(km + (size_t)row * 384 + h * 96 + 80 + 4 * fq, o2); }
                        }
                    } else if (u.pn == 6) {
                        const int cv = bj * 128 + wc * 32 + 4 * fq;
                        bf16_t* d = svt + ((size_t)(row >> 12) * 256 + cv) * SEQ + (row & (SEQ - 1));
#pragma unroll
                        for (int j = 0; j < 4; ++j) { d[(size_t)j * SEQ] = f2bf(acc[ai][bj][m][0][j]); d[(size_t)(j + 16) * SEQ] = f2bf(acc[ai][bj][m][1][j]); }
                        st_bf16x4(P + (size_t)row * PLD + (c0 - 512), acc[ai][bj][m][0]);
                        st_bf16x4(P + (size_t)row * PLD + (c0 - 512) + 16, acc[ai][bj][m][1]);
                    } else {
                        st_bf16x4(P + (size_t)row * PLD + (c0 - 512), acc[ai][bj][m][0]);
                        st_bf16x4(P + (size_t)row * PLD + (c0 - 512) + 16, acc[ai][bj][m][1]);
                    }
                }
            }
    }
};
struct Epi2 {
    bf16_t* qm; bf16_t* km; bf16_t* vm; const float* rope;
    DI void operator()(const Acc& acc, const pg8::Unit& u, int wr, int wc, int fr, int fq) const {
#pragma unroll
        for (int ai = 0; ai < 2; ++ai)
#pragma unroll
            for (int m = 0; m < 4; ++m) {
                const int row = u.pm * 256 + ai * 128 + wr * 64 + m * 16 + fr;
#pragma unroll
                for (int bj = 0; bj < 2; ++bj) {
                    const int grp = u.pn * 8 + bj * 4 + wc;
                    const f32x4 x1 = acc[ai][bj][m][0], x2 = acc[ai][bj][m][1];
                    if (grp < 12) {
                        bf16_t* d = qm + (size_t)row * 384 + grp * 32 + 4 * fq;
                        if (grp % 3 == 2) {
                            const f32x4 cs0 = *(const f32x4*)(rope + (size_t)row * 32 + 8 * fq), cs1 = *(const f32x4*)(rope + (size_t)row * 32 + 8 * fq + 4);
                            f32x4 o1, o2;
                            o1[0] = x1[0] * cs0[0] - x2[0] * cs0[1]; o2[0] = x2[0] * cs0[0] + x1[0] * cs0[1];
                            o1[1] = x1[1] * cs0[2] - x2[1] * cs0[3]; o2[1] = x2[1] * cs0[2] + x1[1] * cs0[3];
                            o1[2] = x1[2] * cs1[0] - x2[2] * cs1[1]; o2[2] = x2[2] * cs1[0] + x1[2] * cs1[1];
                            o1[3] = x1[3] * cs1[2] - x2[3] * cs1[3]; o2[3] = x2[3] * cs1[2] + x1[3] * cs1[3];
                            st_bf16x4(d, o1); st_bf16x4(d + 16, o2);
                        } else { st_bf16x4(d, x1); st_bf16x4(d + 16, x2); }
                    } else if (grp < 28) {
                        const int g2 = grp - 12, head = g2 >> 2, sub = g2 & 3;
                        if (sub < 2) { bf16_t* d = km + (size_t)row * 384 + head * 96 + sub * 32 + 4 * fq; st_bf16x4(d, x1); st_bf16x4(d + 16, x2); }
                        else {
                            bf16_t* d = vm + ((size_t)(row >> 12) * 256 + head * 64 + (sub - 2) * 32 + 4 * fq) * SEQ + (row & (SEQ - 1));
#pragma unroll
                            for (int j = 0; j < 4; ++j) { d[(size_t)j * SEQ] = f2bf(x1[j]); d[(size_t)(j + 16) * SEQ] = f2bf(x2[j]); }
                        }
                    }
                }
            }
    }
};
struct EpiRes {
    const float* hin; float* hout;
    DI void operator()(const Acc& acc, const pg8::Unit& u, int wr, int wc, int fr, int fq) const {
#pragma unroll
        for (int ai = 0; ai < 2; ++ai)
#pragma unroll
            for (int m = 0; m < 4; ++m) {
                const size_t off = (size_t)(u.pm * 256 + ai * 128 + wr * 64 + m * 16 + fr) * DM + u.pn * 256 + wc * 32 + 4 * fq;
#pragma unroll
                for (int bj = 0; bj < 2; ++bj)
#pragma unroll
                    for (int n = 0; n < 2; ++n) { const f32x4 b = *(const f32x4*)(hin + off + bj * 128 + n * 16); *(f32x4*)(hout + off + bj * 128 + n * 16) = b + acc[ai][bj][m][n]; }
            }
    }
};
struct EpiGU {
    bf16_t* act;
    DI void operator()(const Acc& acc, const pg8::Unit& u, int wr, int wc, int fr, int fq) const {
#pragma unroll
        for (int ai = 0; ai < 2; ++ai)
#pragma unroll
            for (int m = 0; m < 4; ++m) {
                const int row = u.pm * 256 + ai * 128 + wr * 64 + m * 16 + fr;
#pragma unroll
                for (int bj = 0; bj < 2; ++bj) {
                    const int grp = u.pn * 8 + bj * 4 + wc;
                    const f32x4 g = acc[ai][bj][m][0], up = acc[ai][bj][m][1];
                    f32x4 o;
#pragma unroll
                    for (int j = 0; j < 4; ++j) o[j] = g[j] * sigmoidf_(g[j]) * up[j];
                    st_bf16x4(act + (size_t)row * FFN + grp * 16 + 4 * fq, o);
                }
            }
    }
};

DI int rowmap(int mode, int n) { return mode == 0 ? n : mode == 1 ? (n < 416 ? n : n + 96) : mode == 2 ? (32 * (n >> 4) + (n & 15)) : (32 * (n >> 4) + 16 + (n & 15)); }
DI void transpose_tile(const float* W, int K, int N, bf16_t* dst, int ldd, int mode, int tile, LAS float* lds) {
    const int ntn = (N + 63) / 64, kt = tile / ntn, nt = tile % ntn, k0 = kt * 64, n0 = nt * 64, tid = ltid();
#pragma unroll
    for (int i = 0; i < 8; ++i) { const int idx = tid + i * NTHR, r = idx >> 6, c = idx & 63; lds[r * 65 + c] = (n0 + c < N) ? W[(size_t)(k0 + r) * N + n0 + c] : 0.f; }
    __syncthreads();
#pragma unroll
    for (int i = 0; i < 8; ++i) { const int idx = tid + i * NTHR, rr = idx >> 6, cc = idx & 63; if (n0 + rr < N) dst[(size_t)rowmap(mode, n0 + rr) * ldd + k0 + cc] = f2bf(lds[cc * 65 + rr]); }
    __syncthreads();
}
DI void rms_rows(const float* src, const float* g, bf16_t* dst, float* dstf) {
    const int lane = ltid() & 63, wv = ltid() >> 6;
    for (int row = lbid() * 8 + wv; row < T; row += gridDim.x * 8) {
        const float* s = src + (size_t)row * DM;
        f32x4 v[4]; float ss = 0.f;
#pragma unroll
        for (int i = 0; i < 4; ++i) { v[i] = *(const f32x4*)(s + i * 256 + lane * 4); ss += v[i][0] * v[i][0] + v[i][1] * v[i][1] + v[i][2] * v[i][2] + v[i][3] * v[i][3]; }
        ss = wave_sum(ss);
        const float rs = rsqrtf(ss * (1.0f / DM) + NORM_EPS);
#pragma unroll
        for (int i = 0; i < 4; ++i) { const f32x4 gg = *(const f32x4*)(g + i * 256 + lane * 4); f32x4 o = v[i] * rs * gg;
            if (dst) st_bf16x4(dst + (size_t)row * DM + i * 256 + lane * 4, o); else *(f32x4*)(dstf + (size_t)row * DM + i * 256 + lane * 4) = o; }
    }
}

DI void phase_convert(PP p, int l, LAS unsigned char* lds) {
    unsigned char* ws = p->ws;
    bf16_t* Win = (bf16_t*)(ws + WS_WIN); bf16_t* Wup = (bf16_t*)(ws + WS_WUP); bf16_t* Wout = (bf16_t*)(ws + WS_WOUT);
    bf16_t* Wgu = (bf16_t*)(ws + WS_WGU); bf16_t* Wdn = (bf16_t*)(ws + WS_WDN); bf16_t* Wlru = (bf16_t*)(ws + WS_WLRU);
    LAS float* lf = (LAS float*)lds;
    const int n0 = 16 * 43, n1 = 256, n2 = 16 * 44, n3 = 16 * 44, n4 = 44 * 16, ntot = n0 + n1 + n2 + n3 + n4;
    for (int t = lbid(); t < ntot; t += gridDim.x) {
        if (t < n0) transpose_tile(p->w_in + (size_t)l * DM * D_IN, DM, D_IN, Win, DM, 1, t, lf);
        else if (t < n0 + n1) transpose_tile(p->w_out + (size_t)l * DM * DM, DM, DM, Wout, DM, 0, t - n0, lf);
        else if (t < n0 + n1 + n2) transpose_tile(p->w_gate + (size_t)l * DM * FFN, DM, FFN, Wgu, DM, 2, t - n0 - n1, lf);
        else if (t < n0 + n1 + n2 + n3) transpose_tile(p->w_up + (size_t)l * DM * FFN, DM, FFN, Wgu, DM, 3, t - n0 - n1 - n2, lf);
        else transpose_tile(p->w_down + (size_t)l * FFN * DM, FFN, DM, Wdn, FFN, 0, t - n0 - n1 - n2 - n3, lf);
    }
    const int gtid = lbid() * NTHR + ltid(), gn = gridDim.x * NTHR;
    for (int i = gtid; i < 96 * DM; i += gn) Win[(size_t)416 * DM + i] = 0;
    const float* wuq = p->w_uq + (size_t)l * 256 * 384; const float* wukv = p->w_ukv + (size_t)l * 128 * 512;
    for (int i = gtid; i < 1024 * 384; i += gn) {
        const int n = i / 384, k = i % 384; float v = 0.f;
        if (n < 384) { if (k < 256) v = wuq[(size_t)k * 384 + n]; }
        else if (n < 896) { if (k >= 256) v = wukv[(size_t)(k - 256) * 512 + (n - 384)]; }
        Wup[i] = f2bf(v);
    }
    for (int i = gtid; i < 2 * 4 * 64 * 64; i += gn) {
        const int ty = i >> 14, n = (i >> 12) & 3, d = (i >> 6) & 63, c = i & 63;
        const float* w = (ty ? p->w_x : p->w_a) + (size_t)l * 4 * 64 * 64;
        Wlru[i] = f2bf(w[(n * 64 + c) * 64 + d]);
    }
    if (l == 0) {
        float* rt = (float*)(ws + WS_ROPE);
        for (int i = gtid; i < T * 16; i += gn) {
            const int row = i >> 4, j = i & 15;
            const float inv = powf(10000.0f, -(float)j / 16.0f);
            const float ang = (float)p->pos[row] * inv;
            float s, c; sincosf(ang, &s, &c);
            rt[2 * i] = c; rt[2 * i + 1] = s;
        }
    }
}

DI void phase_norm_cqkv(PP p, int l) {
    bf16_t* cq = (bf16_t*)(p->ws + WS_CQKV);
    const float* gq = p->q_norm_g + l * 256; const float* gk = p->kv_norm_g + l * 128;
    const int lane = ltid() & 63, wv = ltid() >> 6;
    for (int row = lbid() * 8 + wv; row < T; row += gridDim.x * 8) {
        bf16_t* r = cq + (size_t)row * 384;
        const u32x2 a = *(const u32x2*)(r + lane * 4); const unsigned b = *(const unsigned*)(r + 256 + lane * 2);
        const float a0 = bflo(a.x), a1 = bfhi(a.x), a2 = bflo(a.y), a3 = bfhi(a.y), b0 = bflo(b), b1 = bfhi(b);
        const float sq = wave_sum(a0 * a0 + a1 * a1 + a2 * a2 + a3 * a3), sk = wave_sum(b0 * b0 + b1 * b1);
        const float rq = rsqrtf(sq * (1.0f / 256) + NORM_EPS), rk = rsqrtf(sk * (1.0f / 128) + NORM_EPS);
        const f32x4 g4 = *(const f32x4*)(gq + lane * 4); const f32x2 g2 = *(const f32x2*)(gk + lane * 2);
        u32x2 o; o.x = cvt_pk_bf16(a0 * rq * g4[0], a1 * rq * g4[1]); o.y = cvt_pk_bf16(a2 * rq * g4[2], a3 * rq * g4[3]);
        *(u32x2*)(r + lane * 4) = o; *(unsigned*)(r + 256 + lane * 2) = cvt_pk_bf16(b0 * rk * g2[0], b1 * rk * g2[1]);
    }
}
DI void phase_group_norm(PP p, int l) {
    bf16_t* mix = (bf16_t*)(p->ws + WS_MIX);
    const int lane = ltid() & 63, wv = ltid() >> 6;
    for (int row = lbid() * 8 + wv; row < T; row += gridDim.x * 8) {
#pragma unroll
        for (int gi = 0; gi < 3; gi += 2) {
            bf16_t* r = mix + (size_t)row * DM + gi * 256 + lane * 4;
            const u32x2 a = *(const u32x2*)r;
            const float a0 = bflo(a.x), a1 = bfhi(a.x), a2 = bflo(a.y), a3 = bfhi(a.y);
            const float ss = wave_sum(a0 * a0 + a1 * a1 + a2 * a2 + a3 * a3);
            const float rs = rsqrtf(ss * (1.0f / 256) + NORM_EPS);
            const f32x4 g4 = *(const f32x4*)(p->grp_g + (size_t)l * 768 + gi * 256 + lane * 4);
            u32x2 o; o.x = cvt_pk_bf16(a0 * rs * g4[0], a1 * rs * g4[1]); o.y = cvt_pk_bf16(a2 * rs * g4[2], a3 * rs * g4[3]);
            *(u32x2*)r = o;
        }
    }
}

DI void naive_mla(PP p, int item) {
    const bf16_t* qm = (const bf16_t*)(p->ws + WS_QM); const bf16_t* km = (const bf16_t*)(p->ws + WS_KM); const bf16_t* vm = (const bf16_t*)(p->ws + WS_VM);
    bf16_t* mix = (bf16_t*)(p->ws + WS_MIX);
    const int b = item >> 5, h = (item >> 3) & 3, qc = item & 7;
    const int t = qc * 512 + ltid();
    const size_t row = (size_t)b * SEQ + t;
    float q[96], o[64];
#pragma unroll
    for (int i = 0; i < 48; ++i) { const unsigned u = *(const unsigned*)(qm + row * 384 + h * 96 + 2 * i); q[2 * i] = bflo(u); q[2 * i + 1] = bfhi(u); }
#pragma unroll
    for (int i = 0; i < 64; ++i) o[i] = 0.f;
    float mx = -1e30f, l = 0.f;
    const int kend = __builtin_amdgcn_readfirstlane(qc * 512 + (ltid() | 63));
    const float scale = 0.10206207261596577f;
    for (int k = 0; k <= kend; ++k) {
        const unsigned* kr = (const unsigned*)(km + ((size_t)b * SEQ + k) * 384 + h * 96);
        const unsigned* vr = (const unsigned*)(vm + ((size_t)b * SEQ + k) * 256 + h * 64);
        float s = 0.f;
#pragma unroll
        for (int i = 0; i < 48; ++i) { const unsigned u = kr[i]; s += q[2 * i] * bflo(u) + q[2 * i + 1] * bfhi(u); }
        s *= scale;
        const bool valid = k <= t;
        const float mn = valid ? fmaxf(mx, s) : mx;
        const float alpha = __expf(mx - mn), pr = valid ? __expf(s - mn) : 0.f;
        l = l * alpha + pr; mx = mn;
#pragma unroll
        for (int i = 0; i < 32; ++i) { const unsigned u = vr[i]; o[2 * i] = o[2 * i] * alpha + pr * bflo(u); o[2 * i + 1] = o[2 * i + 1] * alpha + pr * bfhi(u); }
    }
    const float inv = 1.0f / l;
#pragma unroll
    for (int i = 0; i < 32; ++i) *(unsigned*)(mix + row * DM + h * 64 + 2 * i) = cvt_pk_bf16(o[2 * i] * inv, o[2 * i + 1] * inv);
}
DI void naive_sb(PP p, int item) {
    const bf16_t* P = (const bf16_t*)(p->ws + WS_P); bf16_t* mix = (bf16_t*)(p->ws + WS_MIX);
    const int b = item >> 5, h = (item >> 3) & 3, qc = item & 7;
    const int t = qc * 512 + ltid();
    const size_t row = (size_t)b * SEQ + t;
    float q[64], o[64];
#pragma unroll
    for (int i = 0; i < 32; ++i) { const unsigned u = *(const unsigned*)(P + row * PLD + P_SQ + h * 64 + 2 * i); q[2 * i] = bflo(u); q[2 * i + 1] = bfhi(u); }
#pragma unroll
    for (int i = 0; i < 64; ++i) o[i] = 0.f;
    float R = 0.f;
    const int kend = __builtin_amdgcn_readfirstlane(qc * 512 + (ltid() | 63));
    for (int k = kend - 1; k >= 0; --k) {
        const unsigned* kr = (const unsigned*)(P + ((size_t)b * SEQ + k) * PLD + P_SK + h * 64);
        const unsigned* vr = (const unsigned*)(P + ((size_t)b * SEQ + k) * PLD + P_SV + h * 64);
        float z = 0.f;
#pragma unroll
        for (int i = 0; i < 32; ++i) { const unsigned u = kr[i]; z += q[2 * i] * bflo(u) + q[2 * i + 1] * bfhi(u); }
        z *= 0.125f;
        const bool valid = k < t;
        const float lk = -(fmaxf(z, 0.f) + log1pf(__expf(-fabsf(z))));
        const float w = valid ? __expf(z + lk + R) : 0.f;
        R += valid ? lk : 0.f;
#pragma unroll
        for (int i = 0; i < 32; ++i) { const unsigned u = vr[i]; o[2 * i] += w * bflo(u); o[2 * i + 1] += w * bfhi(u); }
    }
#pragma unroll
    for (int i = 0; i < 32; ++i) *(unsigned*)(mix + row * DM + 512 + h * 64 + 2 * i) = cvt_pk_bf16(o[2 * i], o[2 * i + 1]);
}
DI void naive_lru_gates(PP p, int l, LAS unsigned char* lds) {
    const bf16_t* P = (const bf16_t*)(p->ws + WS_P);
    float* Aa = (float*)(p->ws + WS_U); float* Uu = Aa + (size_t)T * 256;
    LAS float* xs = (LAS float*)lds;
    const int tl = ltid() >> 8, ch = ltid() & 255, n = ch >> 6, d = ch & 63;
    const float* cw = p->conv_w + l * 4 * 256; const float cb = p->conv_b[l * 256 + ch];
    const float* wa = p->w_a + (size_t)l * 4 * 4096 + n * 4096; const float* wx = p->w_x + (size_t)l * 4 * 4096 + n * 4096;
    const float ba = p->b_a[l * 256 + ch], bx = p->b_x[l * 256 + ch];
    const float lam = p->lam[l * 256 + ch];
    const float sp = fmaxf(-lam, 0.f) + log1pf(__expf(-fabsf(lam)));
    for (int tile = lbid(); tile < T / 2; tile += gridDim.x) {
        const int row = tile * 2 + tl, s = row & (SEQ - 1);
        float xc = cb;
#pragma unroll
        for (int j = 0; j < 4; ++j) { const int ss = s - 3 + j; if (ss >= 0) xc += cw[j * 256 + ch] * bf2f(P[(size_t)(row - 3 + j) * PLD + P_LX + ch]); }
        xs[tl * 256 + ch] = xc;
        __syncthreads();
        float ra = ba, rx = bx;
#pragma unroll 4
        for (int c = 0; c < 64; ++c) { const float xv = xs[tl * 256 + n * 64 + c]; ra += xv * wa[c * 64 + d]; rx += xv * wx[c * 64 + d]; }
        const float la = -8.0f * sigmoidf_(ra) * sp;
        const float a = __expf(la);
        const float uu = sqrtf(fmaxf(-expm1f(2.0f * la), 0.f)) * sigmoidf_(rx) * xc;
        Aa[(size_t)row * 256 + ch] = a; Uu[(size_t)row * 256 + ch] = uu;
        __syncthreads();
    }
}
DI float gelu_tanh(float x) { const float u = 0.7978845608028654f * (x + 0.044715f * x * x * x); return 0.5f * x * (1.0f + tanhf(u)); }
DI void naive_lru_scan(PP p, int item) {
    const bf16_t* P = (const bf16_t*)(p->ws + WS_P); bf16_t* mix = (bf16_t*)(p->ws + WS_MIX);
    const float* Aa = (const float*)(p->ws + WS_U); const float* Uu = Aa + (size_t)T * 256;
    const int id = item * 512 + ltid(), b = id >> 8, ch = id & 255;
    float h = 0.f;
#pragma unroll 8
    for (int s = 0; s < SEQ; ++s) {
        const size_t row = (size_t)b * SEQ + s;
        h = Aa[row * 256 + ch] * h + Uu[row * 256 + ch];
        mix[row * DM + 256 + ch] = f2bf(h * gelu_tanh(bf2f(P[row * PLD + P_LG + ch])));
    }
}
DI float hg_lower_bound(PP p, int l, int c) {
    float v[DEPTH], mx = -1e30f, s = 0.f;
#pragma unroll
    for (int i = 0; i < DEPTH; ++i) { v[i] = p->lb_logits[i * 256 + c]; mx = fmaxf(mx, v[i]); }
#pragma unroll
    for (int i = 0; i < DEPTH; ++i) { v[i] = __expf(v[i] - mx); s += v[i]; }
    float lb = 0.f;
#pragma unroll
    for (int i = 1; i < DEPTH; ++i) if (i <= l) lb += v[i];
    return lb / s;
}
DI void naive_hgrn(PP p, int l, int item, LAS unsigned char* lds) {
    const bf16_t* P = (const bf16_t*)(p->ws + WS_P); bf16_t* mix = (bf16_t*)(p->ws + WS_MIX);
    LAS float* sf = (LAS float*)lds; LAS float* sk = sf + 128; LAS float* sq = sk + 128; LAS float* sv = sq + 128; LAS float* red = sv + 128;
    const int b = item >> 2, h = item & 3, tid = ltid(), e = tid & 63, dg = tid >> 6;
    const float lb = hg_lower_bound(p, l, h * 64 + e);
    const float ng = p->hg_norm_g[l * 256 + h * 64 + e];
    float st[8];
#pragma unroll
    for (int i = 0; i < 8; ++i) st[i] = 0.f;
    for (int s = 0; s < SEQ; ++s) {
        const size_t row = (size_t)b * SEQ + s; const int pb = (s & 1) * 64;
        if (tid < 64) {
            const float fz = bf2f(P[row * PLD + P_HF + h * 64 + e]);
            sf[pb + e] = fmaxf(lb, 1e-30f) + (1.0f - lb) * sigmoidf_(fz);
            sk[pb + e] = (1.0f - lb) * sigmoidf_(-fz);
            sq[pb + e] = bf2f(P[row * PLD + P_HQ + h * 64 + e]);
        } else if (tid < 128) sv[pb + e] = bf2f(P[row * PLD + P_HI + h * 64 + e]);
        __syncthreads();
        const float v = sv[pb + e]; float part = 0.f;
#pragma unroll
        for (int i = 0; i < 8; ++i) { const int d = dg * 8 + i; st[i] = sf[pb + d] * st[i] + sk[pb + d] * v; part += st[i] * sq[pb + d]; }
        red[(s & 1) * 512 + dg * 64 + e] = part;
        __syncthreads();
        if (tid < 64) {
            float o = 0.f;
#pragma unroll
            for (int i = 0; i < 8; ++i) o += red[(s & 1) * 512 + i * 64 + e];
            const float ss = wave_sum(o * o);
            const float rs = rsqrtf(ss * (1.0f / 64) + NORM_EPS);
            const float g = bf2f(P[row * PLD + P_HG + h * 64 + e]);
            mix[row * DM + 768 + h * 64 + e] = f2bf(o * rs * ng * g * sigmoidf_(g));
        }
    }
    __syncthreads();
}


#define MFMA32(a, b, c) __builtin_amdgcn_mfma_f32_32x32x16_bf16((a), (b), (c), 0, 0, 0)
DI bf16x8 pack8(const f32x16& x, int base) {
    u32x4 r; r.x = cvt_pk_bf16(x[base], x[base + 1]); r.y = cvt_pk_bf16(x[base + 2], x[base + 3]); r.z = cvt_pk_bf16(x[base + 4], x[base + 5]); r.w = cvt_pk_bf16(x[base + 6], x[base + 7]);
    return __builtin_bit_cast(bf16x8, r);
}
template <bool SB>
DI void attn_item(PP p, int b, int h, int qb, LAS unsigned char* lds) {
    constexpr int DK = SB ? 64 : 96, NKS = DK / 16;
    constexpr int KSTR = DK * 2 + 16, VSTR = 144, KBYTES = 64 * KSTR, VBYTES = 64 * VSTR, BUF = KBYTES + VBYTES;
    constexpr int KCH = DK / 8;
    const int tid = ltid(), lane = tid & 63, w = __builtin_amdgcn_readfirstlane(tid >> 6), ql = lane & 31, g = lane >> 5;
    unsigned char* ws = p->ws;
    const size_t rowb = (size_t)b * SEQ;
    const bf16_t* Qg = SB ? (const bf16_t*)(ws + WS_P) + P_SQ + h * 64 : (const bf16_t*)(ws + WS_QM) + h * 96;
    const bf16_t* Kg = SB ? (const bf16_t*)(ws + WS_P) + P_SK + h * 64 : (const bf16_t*)(ws + WS_KM) + h * 96;
    const bf16_t* VTg = (const bf16_t*)(ws + (SB ? WS_SVT : WS_VM)) + (size_t)(b * 4 + h) * 64 * SEQ;
    constexpr int QLD = SB ? PLD : 384;
    const int q0 = qb * 256 + w * 32, myq = q0 + ql;
    bf16x8 qf[NKS];
#pragma unroll
    for (int ks = 0; ks < NKS; ++ks) qf[ks] = *(const bf16x8*)(Qg + (rowb + myq) * QLD + ks * 16 + g * 8);
    f32x16 o[2];
#pragma unroll
    for (int i = 0; i < 16; ++i) { o[0][i] = 0.f; o[1][i] = 0.f; }
    float m_run = -1e30f, lsum = 0.f, R = 0.f;
    bf16x8 Mlo, Mhi, Mone;
    if (SB) {
#pragma unroll
        for (int jj = 0; jj < 8; ++jj) { const int j = 8 * (jj >> 2) + 4 * g + (jj & 3); Mlo[jj] = (j > ql) ? (short)0x3F80 : (short)0; Mhi[jj] = (j + 16 > ql) ? (short)0x3F80 : (short)0; Mone[jj] = (short)0x3F80; }
    }
    const int ntiles = (qb + 1) * 4;
    const int kkey0 = SB ? (tid >> 3) : (tid / 12), kpart0 = SB ? (tid & 7) : (tid % 12);
    const int kkey1 = (tid + 512) / 12, kpart1 = (tid + 512) % 12;
    const int vdv = tid >> 3, vpart = tid & 7;
    u32x4 rk0, rk1, rv;
    rk1 = (u32x4){0u, 0u, 0u, 0u};
#define ATT_LOAD(kt) do { const size_t kr = rowb + (size_t)(kt) * 64; \
        rk0 = *(const u32x4*)(Kg + (kr + kkey0) * QLD + kpart0 * 8); \
        if (!SB && tid < 256) rk1 = *(const u32x4*)(Kg + (kr + kkey1) * QLD + kpart1 * 8); \
        rv = *(const u32x4*)(VTg + (size_t)vdv * SEQ + (size_t)(kt) * 64 + vpart * 8); } while (0)
#define ATT_WRITE(bufi) do { LAS unsigned char* kb_ = lds + (bufi) * BUF; \
        *(LAS u32x4*)(kb_ + kkey0 * KSTR + kpart0 * 16) = rk0; \
        if (!SB && tid < 256) *(LAS u32x4*)(kb_ + kkey1 * KSTR + kpart1 * 16) = rk1; \
        *(LAS u32x4*)(kb_ + KBYTES + vdv * VSTR + vpart * 16) = rv; } while (0)
    { const int kt0 = SB ? ntiles - 1 : 0; ATT_LOAD(kt0); ATT_WRITE(0); }
    __syncthreads();
    for (int it = 0; it < ntiles; ++it) {
        const int kt = SB ? ntiles - 1 - it : it;
        if (it + 1 < ntiles) { const int ktn = SB ? kt - 1 : kt + 1; ATT_LOAD(ktn); }
        const int key0 = kt * 64;
        if (key0 <= q0 + 31) {
            LAS unsigned char* kb = lds + (it & 1) * BUF; LAS unsigned char* vb = kb + KBYTES;
            f32x16 s[2];
#pragma unroll
            for (int i = 0; i < 16; ++i) { s[0][i] = 0.f; s[1][i] = 0.f; }
#pragma unroll
            for (int rt = 0; rt < 2; ++rt)
#pragma unroll
                for (int ks = 0; ks < NKS; ++ks) { const bf16x8 kf = *(const LAS bf16x8*)(kb + (32 * rt + ql) * KSTR + (ks * 16 + g * 8) * 2); s[rt] = MFMA32(kf, qf[ks], s[rt]); }
            const bool domask = (key0 + 63 >= q0);
            bf16x8 pf[4];
            if (!SB) {
                const float sc = 0.10206207261596577f * 1.4426950408889634f;
                float mx = m_run;
#pragma unroll
                for (int rt = 0; rt < 2; ++rt)
#pragma unroll
                    for (int i = 0; i < 16; ++i) { float v = s[rt][i] * sc; const int key = key0 + 32 * rt + 8 * (i >> 2) + 4 * g + (i & 3); if (domask && key > myq) v = -1e30f; s[rt][i] = v; mx = fmaxf(mx, v); }
                mx = fmaxf(mx, __shfl_xor(mx, 32));
                const float alpha = __builtin_amdgcn_exp2f(m_run - mx); m_run = mx;
                float ps = 0.f;
#pragma unroll
                for (int rt = 0; rt < 2; ++rt)
#pragma unroll
                    for (int i = 0; i < 16; ++i) { const float pv = __builtin_amdgcn_exp2f(s[rt][i] - mx); s[rt][i] = pv; ps += pv; }
                lsum = lsum * alpha + ps;
#pragma unroll
                for (int i = 0; i < 16; ++i) { o[0][i] *= alpha; o[1][i] *= alpha; }
            } else {
                const float sc = 0.125f * 1.4426950408889634f;
                f32x16 lk[2]; float lks = 0.f;
#pragma unroll
                for (int rt = 0; rt < 2; ++rt)
#pragma unroll
                    for (int i = 0; i < 16; ++i) {
                        const float z2 = s[rt][i] * sc; const int key = key0 + 32 * rt + 8 * (i >> 2) + 4 * g + (i & 3);
                        const float e = __builtin_amdgcn_exp2f(-fabsf(z2));
                        float l2 = -(fmaxf(z2, 0.f) + __builtin_amdgcn_logf(1.0f + e));
                        const bool valid = !domask || key < myq;
                        l2 = valid ? l2 : 0.f;
                        lk[rt][i] = l2; lks += l2; s[rt][i] = valid ? z2 + l2 : -1e30f;
                    }
                bf16x8 lf[4];
#pragma unroll
                for (int ks = 0; ks < 4; ++ks) lf[ks] = pack8(lk[ks >> 1], 8 * (ks & 1));
                f32x16 lat0, lat1;
#pragma unroll
                for (int i = 0; i < 16; ++i) { lat0[i] = R; lat1[i] = R; }
                lat0 = MFMA32(Mlo, lf[0], lat0); lat0 = MFMA32(Mhi, lf[1], lat0); lat0 = MFMA32(Mone, lf[2], lat0); lat0 = MFMA32(Mone, lf[3], lat0);
                lat1 = MFMA32(Mlo, lf[2], lat1); lat1 = MFMA32(Mhi, lf[3], lat1);
#pragma unroll
                for (int i = 0; i < 16; ++i) { s[0][i] = __builtin_amdgcn_exp2f(s[0][i] + lat0[i]); s[1][i] = __builtin_amdgcn_exp2f(s[1][i] + lat1[i]); }
                lks += __shfl_xor(lks, 32);
                R += lks;
            }
#pragma unroll
            for (int ks = 0; ks < 4; ++ks) pf[ks] = pack8(s[ks >> 1], 8 * (ks & 1));
#pragma unroll
            for (int dvt = 0; dvt < 2; ++dvt)
#pragma unroll
                for (int ks = 0; ks < 4; ++ks) {
                    const u32x2 lo = *(const LAS u32x2*)(vb + (32 * dvt + ql) * VSTR + (16 * ks + 4 * g) * 2);
                    const u32x2 hi = *(const LAS u32x2*)(vb + (32 * dvt + ql) * VSTR + (16 * ks + 8 + 4 * g) * 2);
                    u32x4 vv; vv.x = lo.x; vv.y = lo.y; vv.z = hi.x; vv.w = hi.y;
                    o[dvt] = MFMA32(__builtin_bit_cast(bf16x8, vv), pf[ks], o[dvt]);
                }
        }
        if (it + 1 < ntiles) ATT_WRITE((it + 1) & 1);
        __syncthreads();
    }
#undef ATT_LOAD
#undef ATT_WRITE
    float inv = 1.0f;
    if (!SB) { const float lt = lsum + __shfl_xor(lsum, 32); inv = 1.0f / lt; }
    bf16_t* dst = (bf16_t*)(ws + WS_MIX) + (rowb + myq) * DM + (SB ? 512 : 0) + h * 64 + 4 * g;
#pragma unroll
    for (int dvt = 0; dvt < 2; ++dvt)
#pragma unroll
        for (int k4 = 0; k4 < 4; ++k4) {
            f32x4 v; v[0] = o[dvt][4 * k4] * inv; v[1] = o[dvt][4 * k4 + 1] * inv; v[2] = o[dvt][4 * k4 + 2] * inv; v[3] = o[dvt][4 * k4 + 3] * inv;
            st_bf16x4(dst + 32 * dvt + 8 * k4, v);
        }
}
#define DBG_SB_NAIVE 0
DI void attn_phase_items(PP p, LAS unsigned char* lds) {
    const int c = lbid(), G = gridDim.x;
    for (int r = 0; r * G < 1024; ++r) {
        const int L = r * G + ((r & 1) ? (G - 1 - c) : c);
        if (L >= 1024) continue;
        const int qb = 15 - (L >> 6), sub = L & 63, bh = sub & 31;
        if (sub < 32) { if (DBG_SB_NAIVE == 0) attn_item<true>(p, bh >> 2, bh & 3, qb, lds); } else attn_item<false>(p, bh >> 2, bh & 3, qb, lds);
    }
}


template <int MODE>
DI void hgrn_item(PP p, int l, int item, LAS unsigned char* lds) {
    constexpr int STR = 144, TILE = 64 * STR;
    LAS unsigned char* QE = lds; LAS unsigned char* KEm = lds + TILE; LAS unsigned char* QEX = lds + 2 * TILE; LAS unsigned char* KET = lds + 3 * TILE; LAS unsigned char* VT = lds + 4 * TILE;
    LAS float* gt = (LAS float*)(lds + 5 * TILE);
    const int tid = ltid(), lane = tid & 63, w = __builtin_amdgcn_readfirstlane(tid >> 6), ql = lane & 31, g = lane >> 5;
    const int bh = item >> 6, c = item & 63, b = bh >> 2, h = bh & 3;
    const size_t row0 = (size_t)b * SEQ + c * 64;
    unsigned char* ws = p->ws;
    const bf16_t* P = (const bf16_t*)(ws + WS_P);
    const int d = lane;
    const float lb = hg_lower_bound(p, l, h * 64 + d);
    float lf[8], kk[8], qq[8]; unsigned vraw[8];
    float run = 0.f;
#pragma unroll
    for (int i = 0; i < 8; ++i) {
        const size_t row = row0 + w * 8 + i;
        const float fz = bf2f(P[row * PLD + P_HF + h * 64 + d]);
        if (MODE == 1) qq[i] = bf2f(P[row * PLD + P_HQ + h * 64 + d]);
        vraw[i] = P[row * PLD + P_HI + h * 64 + d];
        const float sig = sigmoidf_(fz);
        const float f = fmaxf(lb, 1e-30f) + (1.0f - lb) * sig;
        run += __logf(f); lf[i] = run; kk[i] = (1.0f - lb) * (1.0f - sig);
    }
    gt[w * 64 + d] = run;
    { u32x4 vp; vp.x = vraw[0] | (vraw[1] << 16); vp.y = vraw[2] | (vraw[3] << 16); vp.z = vraw[4] | (vraw[5] << 16); vp.w = vraw[6] | (vraw[7] << 16);
      *(LAS u32x4*)(VT + d * STR + w * 16) = vp; }
    __syncthreads();
    float off = 0.f, cref = 0.f, last = 0.f;
#pragma unroll
    for (int w2 = 0; w2 < 8; ++w2) { const float gv = gt[w2 * 64 + d]; if (w2 < w) off += gv; if (w2 < 4) cref += gv; last += gv; }
    float kxs[8];
#pragma unroll
    for (int i = 0; i < 8; ++i) {
        const float cum = off + lf[i]; const int tok = w * 8 + i;
        if (MODE == 1) {
            ((LAS bf16_t*)(QE + tok * STR))[d] = f2bf(qq[i] * __expf(cum - cref));
            ((LAS bf16_t*)(KEm + tok * STR))[d] = f2bf(kk[i] * __expf(cref - cum));
            ((LAS bf16_t*)(QEX + tok * STR))[d] = f2bf(qq[i] * __expf(cum));
        } else kxs[i] = kk[i] * __expf(last - cum);
    }
    if (MODE == 0) {
        u32x4 kp; kp.x = cvt_pk_bf16(kxs[0], kxs[1]); kp.y = cvt_pk_bf16(kxs[2], kxs[3]); kp.z = cvt_pk_bf16(kxs[4], kxs[5]); kp.w = cvt_pk_bf16(kxs[6], kxs[7]);
        *(LAS u32x4*)(KET + d * STR + w * 16) = kp;
        if (w == 0) ((float*)(ws + WS_HDECAY))[(size_t)item * 64 + d] = __expf(last);
    }
    __syncthreads();
    if (MODE == 0) {
        if (w >= 4) {
            const int et = (w - 4) >> 1, dt = (w - 4) & 1;
            f32x16 acc;
#pragma unroll
            for (int i = 0; i < 16; ++i) acc[i] = 0.f;
#pragma unroll
            for (int ks = 0; ks < 4; ++ks) {
                const bf16x8 a = *(const LAS bf16x8*)(VT + (32 * et + ql) * STR + (16 * ks + 8 * g) * 2);
                const bf16x8 bb = *(const LAS bf16x8*)(KET + (32 * dt + ql) * STR + (16 * ks + 8 * g) * 2);
                acc = MFMA32(a, bb, acc);
            }
            float* dl = (float*)(ws + WS_HDELTA) + (size_t)item * 4096 + 32 * dt + ql;
#pragma unroll
            for (int i = 0; i < 16; ++i) { const int e = 32 * et + 8 * (i >> 2) + 4 * g + (i & 3); dl[e * 64] = acc[i]; }
        }
    } else {
        if (w < 2) {
            const int tt = w;
            f32x16 st0, st1, o0, o1;
#pragma unroll
            for (int i = 0; i < 16; ++i) { st0[i] = 0.f; st1[i] = 0.f; o0[i] = 0.f; o1[i] = 0.f; }
#pragma unroll
            for (int ks = 0; ks < 4; ++ks) {
                const bf16x8 bq = *(const LAS bf16x8*)(QE + (32 * tt + ql) * STR + (16 * ks + 8 * g) * 2);
                const bf16x8 a0 = *(const LAS bf16x8*)(KEm + ql * STR + (16 * ks + 8 * g) * 2);
                st0 = MFMA32(a0, bq, st0);
                if (tt == 1) { const bf16x8 a1 = *(const LAS bf16x8*)(KEm + (32 + ql) * STR + (16 * ks + 8 * g) * 2); st1 = MFMA32(a1, bq, st1); }
            }
#pragma unroll
            for (int i = 0; i < 16; ++i) { const bool ok = (8 * (i >> 2) + 4 * g + (i & 3)) <= ql; if (tt == 0) st0[i] = ok ? st0[i] : 0.f; else st1[i] = ok ? st1[i] : 0.f; }
            bf16x8 pf[4]; pf[0] = pack8(st0, 0); pf[1] = pack8(st0, 8); pf[2] = pack8(st1, 0); pf[3] = pack8(st1, 8);
#pragma unroll
            for (int ks = 0; ks < 4; ++ks) {
                if (ks < 2 || tt == 1) {
#pragma unroll
                    for (int et = 0; et < 2; ++et) {
                        const u32x2 lo = *(const LAS u32x2*)(VT + (32 * et + ql) * STR + (16 * ks + 4 * g) * 2);
                        const u32x2 hi = *(const LAS u32x2*)(VT + (32 * et + ql) * STR + (16 * ks + 8 + 4 * g) * 2);
                        u32x4 vv; vv.x = lo.x; vv.y = lo.y; vv.z = hi.x; vv.w = hi.y;
                        if (et == 0) o0 = MFMA32(__builtin_bit_cast(bf16x8, vv), pf[ks], o0); else o1 = MFMA32(__builtin_bit_cast(bf16x8, vv), pf[ks], o1);
                    }
                }
            }
            const bf16_t* stg = (const bf16_t*)(ws + WS_HSTATE) + (size_t)item * 4096;
#pragma unroll
            for (int ks = 0; ks < 4; ++ks) {
                const bf16x8 bqx = *(const LAS bf16x8*)(QEX + (32 * tt + ql) * STR + (16 * ks + 8 * g) * 2);
                const bf16x8 s0 = *(const bf16x8*)(stg + ql * 64 + 16 * ks + 8 * g);
                const bf16x8 s1 = *(const bf16x8*)(stg + (32 + ql) * 64 + 16 * ks + 8 * g);
                o0 = MFMA32(s0, bqx, o0); o1 = MFMA32(s1, bqx, o1);
            }
            float ss = 0.f;
#pragma unroll
            for (int i = 0; i < 16; ++i) ss += o0[i] * o0[i] + o1[i] * o1[i];
            ss += __shfl_xor(ss, 32);
            const float rs = rsqrtf(ss * (1.0f / 64) + NORM_EPS);
            const size_t row = row0 + 32 * tt + ql;
            const float* ng = p->hg_norm_g + l * 256 + h * 64;
#pragma unroll
            for (int et = 0; et < 2; ++et)
#pragma unroll
                for (int k4 = 0; k4 < 4; ++k4) {
                    const int e = 32 * et + 8 * k4 + 4 * g;
                    const f32x4 gn = *(const f32x4*)(ng + e);
                    const u32x2 gr = *(const u32x2*)(P + row * PLD + P_HG + h * 64 + e);
                    const float g0 = bflo(gr.x), g1 = bfhi(gr.x), g2 = bflo(gr.y), g3 = bfhi(gr.y);
                    f32x4 v;
                    v[0] = (et ? o1[4 * k4] : o0[4 * k4]) * rs * gn[0] * g0 * sigmoidf_(g0);
                    v[1] = (et ? o1[4 * k4 + 1] : o0[4 * k4 + 1]) * rs * gn[1] * g1 * sigmoidf_(g1);
                    v[2] = (et ? o1[4 * k4 + 2] : o0[4 * k4 + 2]) * rs * gn[2] * g2 * sigmoidf_(g2);
                    v[3] = (et ? o1[4 * k4 + 3] : o0[4 * k4 + 3]) * rs * gn[3] * g3 * sigmoidf_(g3);
                    st_bf16x4((bf16_t*)(ws + WS_MIX) + row * DM + 768 + h * 64 + e, v);
                }
        }
    }
    __syncthreads();
}
DI void hgrn_carry(PP p) {
    unsigned char* ws = p->ws;
    const float* dl = (const float*)(ws + WS_HDELTA); const float* dc = (const float*)(ws + WS_HDECAY); bf16_t* st = (bf16_t*)(ws + WS_HSTATE);
    for (int id = lbid() * NTHR + ltid(); id < 32 * 4096; id += gridDim.x * NTHR) {
        const int bh = id >> 12, x = id & 4095, d = x & 63;
        float sv = 0.f;
#pragma unroll 8
        for (int c = 0; c < 64; ++c) {
            const size_t it = (size_t)bh * 64 + c;
            st[it * 4096 + x] = f2bf(sv);
            sv = dc[it * 64 + d] * sv + dl[it * 4096 + x];
        }
    }
}


template <int MODE>
DI void lru_item(PP p, int l, int item, LAS unsigned char* lds) {
    constexpr int XS = 528;
    LAS float* XF = (LAS float*)lds;
    LAS unsigned char* XB = lds + 65536;
    const int tid = ltid(), lane = tid & 63, w = __builtin_amdgcn_readfirstlane(tid >> 6), ql = lane & 31, g = lane >> 5;
    const int b = item >> 6, c = item & 63;
    const size_t row0 = (size_t)b * SEQ + c * 64;
    unsigned char* ws = p->ws;
    const bf16_t* P = (const bf16_t*)(ws + WS_P);
    {
        const int ch = tid & 255, half = tid >> 8;
        const float* cw = p->conv_w + l * 1024; const float w0 = cw[ch], w1 = cw[256 + ch], w2 = cw[512 + ch], w3 = cw[768 + ch], cb = p->conv_b[l * 256 + ch];
        const int t0 = half * 32;
        float x0 = 0.f, x1 = 0.f, x2 = 0.f;
        if (c * 64 + t0 >= 3) { x0 = bf2f(P[(row0 + t0 - 3) * PLD + P_LX + ch]); x1 = bf2f(P[(row0 + t0 - 2) * PLD + P_LX + ch]); x2 = bf2f(P[(row0 + t0 - 1) * PLD + P_LX + ch]); }
#pragma unroll 8
        for (int t = 0; t < 32; ++t) {
            const float x3 = bf2f(P[(row0 + t0 + t) * PLD + P_LX + ch]);
            const float xc = cb + w0 * x0 + w1 * x1 + w2 * x2 + w3 * x3;
            XF[(t0 + t) * 256 + ch] = xc; ((LAS bf16_t*)(XB + (t0 + t) * XS))[ch] = f2bf(xc);
            x0 = x1; x1 = x2; x2 = x3;
        }
    }
    __syncthreads();
    const int n = w >> 1, dh = w & 1, ch = n * 64 + dh * 32 + ql;
    f32x16 ra[2], rx[2];
#pragma unroll
    for (int i = 0; i < 16; ++i) { ra[0][i] = 0.f; ra[1][i] = 0.f; rx[0][i] = 0.f; rx[1][i] = 0.f; }
    {
        const bf16_t* wl = (const bf16_t*)(ws + WS_WLRU) + (size_t)(n * 64 + dh * 32 + ql) * 64;
#pragma unroll
        for (int ks = 0; ks < 4; ++ks) {
            const bf16x8 ba = *(const bf16x8*)(wl + 16 * ks + 8 * g), bx = *(const bf16x8*)(wl + 16384 + 16 * ks + 8 * g);
#pragma unroll
            for (int rt = 0; rt < 2; ++rt) {
                const bf16x8 a = *(const LAS bf16x8*)(XB + (32 * rt + ql) * XS + (n * 64 + 16 * ks + 8 * g) * 2);
                ra[rt] = MFMA32(a, ba, ra[rt]); rx[rt] = MFMA32(a, bx, rx[rt]);
            }
        }
    }
    const float ba_ = p->b_a[l * 256 + ch], bx_ = p->b_x[l * 256 + ch], lam = p->lam[l * 256 + ch];
    const float sp8 = -8.0f * (fmaxf(-lam, 0.f) + log1pf(__expf(-fabsf(lam))));
#pragma unroll
    for (int rt = 0; rt < 2; ++rt)
#pragma unroll
        for (int i = 0; i < 16; ++i) {
            const int tok = 32 * rt + 8 * (i >> 2) + 4 * g + (i & 3);
            const float la = sp8 * sigmoidf_(ra[rt][i] + ba_);
            const float a = __expf(la);
            const float u = sqrtf(fmaxf(-expm1f(2.0f * la), 0.f)) * sigmoidf_(rx[rt][i] + bx_) * XF[tok * 256 + ch];
            ra[rt][i] = a; rx[rt][i] = u;
        }
    float gA[8], gB[8], pA[8], pB[8];
#pragma unroll
    for (int k = 0; k < 8; ++k) {
        float A = 1.f, B = 0.f;
#pragma unroll
        for (int j = 0; j < 4; ++j) { const float a = ra[k >> 2][4 * (k & 3) + j], u = rx[k >> 2][4 * (k & 3) + j]; B = a * B + u; A = a * A; }
        gA[k] = A; gB[k] = B; pA[k] = __shfl_xor(A, 32); pB[k] = __shfl_xor(B, 32);
    }
    if (MODE == 0) {
        float A = 1.f, B = 0.f;
#pragma unroll
        for (int k = 0; k < 8; ++k) {
            const float fA = g ? pA[k] : gA[k], fB = g ? pB[k] : gB[k], sA = g ? gA[k] : pA[k], sB = g ? gB[k] : pB[k];
            B = fA * B + fB; A = fA * A; B = sA * B + sB; A = sA * A;
        }
        if (g == 0) ((f32x2*)(ws + WS_LAGG))[(size_t)item * 256 + ch] = (f32x2){A, B};
        __syncthreads();
        return;
    }
    float H = 0.f;
    {
        const f32x2* ag = (const f32x2*)(ws + WS_LAGG) + (size_t)b * 64 * 256 + ch;
#pragma unroll 8
        for (int c2 = 0; c2 < c; ++c2) { const f32x2 v = ag[(size_t)c2 * 256]; H = v[0] * H + v[1]; }
    }
    float hin[8];
#pragma unroll
    for (int k = 0; k < 8; ++k) {
        const float fA = g ? pA[k] : gA[k], fB = g ? pB[k] : gB[k], sA = g ? gA[k] : pA[k], sB = g ? gB[k] : pB[k];
        const float h1 = H; H = fA * H + fB; const float h2 = H; H = sA * H + sB;
        hin[k] = g ? h2 : h1;
    }
    __syncthreads();
#pragma unroll
    for (int k = 0; k < 8; ++k) {
        float hh = hin[k];
#pragma unroll
        for (int j = 0; j < 4; ++j) {
            const int rt = k >> 2, i = 4 * (k & 3) + j, tok = 32 * rt + 8 * (i >> 2) + 4 * g + (i & 3);
            hh = ra[rt][i] * hh + rx[rt][i];
            const float gate = bf2f(P[(row0 + tok) * PLD + P_LG + ch]);
            XF[tok * 256 + ch] = hh * gelu_tanh(gate);
        }
    }
    __syncthreads();
    {
        const int tok = tid >> 3, part = tid & 7;
        f32x4 v[8]; float ss = 0.f;
#pragma unroll
        for (int i = 0; i < 8; ++i) { v[i] = *(const LAS f32x4*)(XF + tok * 256 + part * 32 + i * 4); ss += v[i][0] * v[i][0] + v[i][1] * v[i][1] + v[i][2] * v[i][2] + v[i][3] * v[i][3]; }
        ss += __shfl_xor(ss, 1); ss += __shfl_xor(ss, 2); ss += __shfl_xor(ss, 4);
        const float rs = rsqrtf(ss * (1.0f / 256) + NORM_EPS);
        const float* gg = p->grp_g + (size_t)l * 768 + 256 + part * 32;
        bf16_t* dst = (bf16_t*)(ws + WS_MIX) + (row0 + tok) * DM + 256 + part * 32;
#pragma unroll
        for (int i = 0; i < 8; ++i) { const f32x4 g4 = *(const f32x4*)(gg + i * 4); st_bf16x4(dst + i * 4, v[i] * rs * g4); }
    }
    __syncthreads();
}

constexpr int PH_PER_LAYER = 10, NSTEPS = DEPTH * PH_PER_LAYER + 1;
struct EpiAny {
    int kind; void* a0; void* a1; void* a2; void* a3; void* a4;
    DI void operator()(const Acc& acc, const pg8::Unit& u, int wr, int wc, int fr, int fq) const {
        asm volatile("" : "+v"(fr), "+v"(fq));
        switch (kind) {
        case 0: { Epi1 e{(bf16_t*)a0, (bf16_t*)a1, (bf16_t*)a2, (const float*)a3, (bf16_t*)a4}; e(acc, u, wr, wc, fr, fq); } break;
        case 1: { Epi2 e{(bf16_t*)a0, (bf16_t*)a1, (bf16_t*)a2, (const float*)a3}; e(acc, u, wr, wc, fr, fq); } break;
        case 2: { EpiRes e{(const float*)a0, (float*)a1}; e(acc, u, wr, wc, fr, fq); } break;
        default: { EpiGU e{(bf16_t*)a0}; e(acc, u, wr, wc, fr, fq); } break;
        }
    }
};

DI void run_step(PP p, int step, LAS unsigned char* lds) {
    unsigned char* ws = p->ws;
    const int l = step / PH_PER_LAYER, ph = step % PH_PER_LAYER;
    const float* hin = (l == 0) ? p->x : p->out;
    if (step == NSTEPS - 1) { rms_rows(p->out, p->fin_g, nullptr, p->out); return; }
    if (ph == 1 || ph == 3 || ph == 6 || ph == 8 || ph == 9) {
        pg8::Gemm g; EpiAny E;
        if (ph == 1) { g = pg8::Gemm{(const bf16_t*)(ws + WS_U), (const bf16_t*)(ws + WS_WIN), T, NPROJ, DM}; E = EpiAny{0, ws + WS_CQKV, ws + WS_P, ws + WS_KM, ws + WS_ROPE, ws + WS_SVT}; }
        else if (ph == 3) { g = pg8::Gemm{(const bf16_t*)(ws + WS_CQKV), (const bf16_t*)(ws + WS_WUP), T, 1024, 384}; E = EpiAny{1, ws + WS_QM, ws + WS_KM, ws + WS_VM, ws + WS_ROPE, nullptr}; }
        else if (ph == 6) { g = pg8::Gemm{(const bf16_t*)(ws + WS_MIX), (const bf16_t*)(ws + WS_WOUT), T, DM, DM}; E = EpiAny{2, (void*)hin, p->out, nullptr, nullptr, nullptr}; }
        else if (ph == 8) { g = pg8::Gemm{(const bf16_t*)(ws + WS_U), (const bf16_t*)(ws + WS_WGU), T, 2 * FFN, DM}; E = EpiAny{3, ws + WS_ACT, nullptr, nullptr, nullptr, nullptr}; }
        else { g = pg8::Gemm{(const bf16_t*)(ws + WS_ACT), (const bf16_t*)(ws + WS_WDN), T, DM, FFN}; E = EpiAny{2, p->out, p->out, nullptr, nullptr, nullptr}; }
        pg8::StaticOrder S; S.init(g.M, g.N, gridDim.x, lbid());
        pg8::gemm_phase(lds, g, S, E);
        if (ph == 3) hgrn_carry(p);
        return;
    }
    switch (ph) {
    case 0: phase_convert(p, l, lds); rms_rows(hin, p->ln1_g + l * DM, (bf16_t*)(ws + WS_U), nullptr); break;
    case 2: phase_norm_cqkv(p, l); for (int it = lbid(); it < 512; it += gridDim.x) lru_item<0>(p, l, it, lds); for (int it = lbid(); it < 2048; it += gridDim.x) hgrn_item<0>(p, l, it, lds); break;
    case 4: {
        attn_phase_items(p, lds);
        if (DBG_SB_NAIVE) naive_sb(p, lbid());
        for (int it = lbid(); it < 2048; it += gridDim.x) hgrn_item<1>(p, l, it, lds);
        for (int it = lbid(); it < 512; it += gridDim.x) lru_item<1>(p, l, it, lds);
        } break;
    case 5: phase_group_norm(p, l); break;
    case 7: rms_rows(p->out, p->ln2_g + l * DM, (bf16_t*)(ws + WS_U), nullptr); break;
    }
}

__global__ void __launch_bounds__(NTHR, 2) mega(Params p, int step_lo, int step_hi) {
    extern __shared__ __attribute__((aligned(16))) unsigned char lds_raw[];
    LAS unsigned char* lds = (LAS unsigned char*)lds_raw;
    for (int step = step_lo; step < step_hi; ++step) {
        PP pp = (PP)__builtin_amdgcn_kernarg_segment_ptr(); asm volatile("" : "+s"(pp));
        run_step(pp, step, lds);
        if (step + 1 < step_hi) { __threadfence(); cg::this_grid().sync(); }
    }
}

extern "C" void kernel_launch(void* const* d_in, const int* in_sizes, int n_in, void* d_out, int out_size, void* d_ws, size_t ws_size, hipStream_t stream) {
    static int inited = 0;
    if (!inited) {
        if (ws_size < WS_END) { fprintf(stderr, "kernel_launch: workspace too small: %zu < %zu\n", ws_size, (size_t)WS_END); return; }
        if (hipFuncSetAttribute((const void*)mega, hipFuncAttributeMaxDynamicSharedMemorySize, LDS_BYTES) != hipSuccess) { fprintf(stderr, "hipFuncSetAttribute failed\n"); return; }
        inited = 1;
    }
    Params p{};
    p.x = (const float*)d_in[0]; p.pos = (const int*)d_in[1]; p.ln1_g = (const float*)d_in[2]; p.w_in = (const float*)d_in[3]; p.q_norm_g = (const float*)d_in[4];
    p.w_uq = (const float*)d_in[5]; p.kv_norm_g = (const float*)d_in[6]; p.w_ukv = (const float*)d_in[7]; p.conv_w = (const float*)d_in[8]; p.conv_b = (const float*)d_in[9];
    p.w_a = (const float*)d_in[10]; p.b_a = (const float*)d_in[11]; p.w_x = (const float*)d_in[12]; p.b_x = (const float*)d_in[13]; p.lam = (const float*)d_in[14];
    p.lb_logits = (const float*)d_in[15]; p.hg_norm_g = (const float*)d_in[16]; p.grp_g = (const float*)d_in[17]; p.w_out = (const float*)d_in[18]; p.ln2_g = (const float*)d_in[19];
    p.w_gate = (const float*)d_in[20]; p.w_up = (const float*)d_in[21]; p.w_down = (const float*)d_in[22]; p.fin_g = (const float*)d_in[23];
    p.out = (float*)d_out; p.ws = (unsigned char*)d_ws;
    int lo = 0, hi = NSTEPS;
    void* args[] = {&p, &lo, &hi};
    hipError_t e = hipLaunchCooperativeKernel((const void*)mega, dim3(256), dim3(NTHR), args, LDS_BYTES, stream);
    if (e != hipSuccess) fprintf(stderr, "cooperative launch failed: %s\n", hipGetErrorString(e));
}
```
